# Optimizing an MI355X kernel written in HIP

```python
import math
import jax, jax.numpy as jnp
from jax import lax
import numpy as np


D_MODEL = 2048
BATCH = 1
SEQ = 8192
DEPTH = 1

MIX_WIDTH = D_MODEL
SSM_WIDTH = MIX_WIDTH // 2
NA_WIDTH = MIX_WIDTH - SSM_WIDTH
SSM_GROUP = 16
SSM_GROUPS = SSM_WIDTH // SSM_GROUP
SSM_STATE = 64
DT_MIN = 1e-3
DT_MAX = 1e-1
NA_HEAD_DIM = 64
NA_HEADS = NA_WIDTH // NA_HEAD_DIM
GRID_W = 64
NA_KH_MAX = 8
NA_KW = 16
N_EXPERTS = 32
TOP_K = 4
D_FF = D_MODEL
SWIGLU_LIMIT = 7.0
SWIGLU_ALPHA = 1.702
MOE_BLOCK = 128
RMS_EPS = 1e-5

kernel_name = 'hymba_s5_natten_moe_encoder'


def rmsnorm(x, g):
    xf = x.astype(jnp.float32)
    y = xf * lax.rsqrt(jnp.mean(xf * xf, axis=-1, keepdims=True) + RMS_EPS)
    return (y * g.astype(jnp.float32)).astype(x.dtype)


def _s5_scan(ug, lam_re, lam_im, log_dt, b_re, b_im, c_re, c_im, reverse):
    f32 = jnp.float32
    lam = lax.complex(jnp.minimum(lam_re.astype(f32), -1e-4), lam_im.astype(f32))
    dt = jnp.exp(log_dt.astype(f32))[:, None]
    lam_bar = jnp.exp(lam * dt)
    b = lax.complex(b_re.astype(f32), b_im.astype(f32))
    b_bar = ((lam_bar - 1.0) / lam)[..., None] * b
    bu = jnp.einsum('blgc,gpc->blgp', ug.astype(jnp.complex64), b_bar)
    a = jnp.broadcast_to(lam_bar, bu.shape)

    def combine(left, right):
        a_l, s_l = left
        a_r, s_r = right
        return a_r * a_l, a_r * s_l + s_r

    _, states = lax.associative_scan(combine, (a, bu), reverse=reverse, axis=1)
    c = lax.complex(c_re.astype(f32), c_im.astype(f32))
    return jnp.einsum('blgp,gcp->blgc', states, c).real


def _s5_bidirectional(u, lam_re_f, lam_im_f, log_dt_f, b_re_f, b_im_f, c_re_f, c_im_f,
                      lam_re_b, lam_im_b, log_dt_b, b_re_b, b_im_b, c_re_b, c_im_b,
                      d, w_glu, b_glu):
    f32 = jnp.float32
    bsz, l, _ = u.shape
    uf = u.astype(f32)
    ug = uf.reshape(bsz, l, SSM_GROUPS, SSM_GROUP)
    y = (_s5_scan(ug, lam_re_f, lam_im_f, log_dt_f, b_re_f, b_im_f, c_re_f, c_im_f, False)
         + _s5_scan(ug, lam_re_b, lam_im_b, log_dt_b, b_re_b, b_im_b, c_re_b, c_im_b, True))
    y = y.reshape(bsz, l, SSM_WIDTH) + d.astype(f32) * uf
    y = jax.nn.gelu(y)
    y = y * jax.nn.sigmoid(y @ w_glu.astype(f32) + b_glu.astype(f32))
    return y.astype(u.dtype)


def _neighbourhood_attention(q, k, v, rpb):
    bsz, l, h, dh = q.shape
    rows = l // GRID_W
    kh = min(NA_KH_MAX, rows)
    kw = NA_KW
    q = q.reshape(bsz, rows, GRID_W, h, dh)
    k = k.reshape(bsz, rows, GRID_W, h, dh)
    v = v.reshape(bsz, rows, GRID_W, h, dh)
    r = jnp.arange(rows)
    row_start = jnp.clip(r - kh // 2, 0, rows - kh)
    row_idx = row_start[:, None] + jnp.arange(kh)[None, :]
    k_blk = jnp.take(k, row_idx, axis=1)
    v_blk = jnp.take(v, row_idx, axis=1)
    c = jnp.arange(GRID_W)
    col_start = jnp.clip(c - kw // 2, 0, GRID_W - kw)
    col_valid = (c[None, :] >= col_start[:, None]) & (c[None, :] < col_start[:, None] + kw)
    dr = row_idx - r[:, None] + (NA_KH_MAX - 1)
    dc = jnp.clip(c[None, :] - c[:, None], -(kw - 1), kw - 1) + (kw - 1)
    bias = rpb.astype(jnp.float32)[:, dr[:, None, :, None], dc[None, :, None, :]]
    bias = jnp.transpose(bias, (1, 0, 2, 3, 4))
    scale = dh ** -0.5
    s = jnp.einsum('brqhd,brkwhd->brhqkw', q, k_blk).astype(jnp.float32) * scale + bias[None]
    s = jnp.where(col_valid[:, None, :], s, -jnp.inf)
    p = jax.nn.softmax(s.reshape(bsz, rows, h, GRID_W, kh * GRID_W), axis=-1)
    p = p.reshape(bsz, rows, h, GRID_W, kh, GRID_W).astype(v.dtype)
    out = jnp.einsum('brhqkw,brkwhd->brqhd', p, v_blk)
    return out.reshape(bsz, l, h * dh)


def _moe(hn, w_router, b_router, w_gate, b_gate, w_up, b_up, w_down, b_down):
    bsz, l, d = hn.shape
    n = bsz * l
    xf = hn.reshape(n, d)
    logits = (xf @ w_router).astype(jnp.float32) + b_router.astype(jnp.float32)
    top_val, top_idx = lax.top_k(logits, TOP_K)
    gates = jax.nn.softmax(top_val, axis=-1)
    flat_e = top_idx.reshape(-1)
    flat_tok = jnp.repeat(jnp.arange(n, dtype=jnp.int32), TOP_K)
    flat_g = gates.reshape(-1)
    order = jnp.argsort(flat_e)
    sorted_e = flat_e[order]
    counts = jnp.bincount(flat_e, length=N_EXPERTS)
    starts = jnp.cumsum(counts) - counts
    padded = (counts + MOE_BLOCK - 1) // MOE_BLOCK * MOE_BLOCK
    padded_end = jnp.cumsum(padded)
    padded_start = padded_end - padded
    rank = jnp.arange(n * TOP_K) - starts[sorted_e]
    dest = padded_start[sorted_e] + rank
    n_blocks = -(-(n * TOP_K) // MOE_BLOCK) + N_EXPERTS
    n_rows = n_blocks * MOE_BLOCK
    row_tok = jnp.zeros((n_rows,), jnp.int32).at[dest].set(flat_tok[order])
    row_gate = jnp.zeros((n_rows,), jnp.float32).at[dest].set(flat_g[order])
    block_start = jnp.arange(n_blocks) * MOE_BLOCK
    block_e = jnp.minimum(jnp.searchsorted(padded_end, block_start, side='right'), N_EXPERTS - 1)
    xs = xf[row_tok].reshape(n_blocks, MOE_BLOCK, d)

    def expert_block(args):
        xb, e = args
        g = jnp.minimum(xb @ w_gate[e] + b_gate[e], SWIGLU_LIMIT)
        u = jnp.clip(xb @ w_up[e] + b_up[e], -SWIGLU_LIMIT, SWIGLU_LIMIT)
        act = (u + 1.0) * (g * jax.nn.sigmoid(SWIGLU_ALPHA * g))
        return act @ w_down[e] + b_down[e]

    ys = lax.map(expert_block, (xs, block_e)).reshape(n_rows, d)
    ys = ys * row_gate[:, None].astype(ys.dtype)
    out = jax.ops.segment_sum(ys, row_tok, num_segments=n)
    return out.reshape(bsz, l, d)


def setup_inputs(seed: int = 0) -> dict:
    key = jax.random.key(seed)
    keys = iter(jax.random.split(key, 48))
    f32 = jnp.float32
    L = DEPTH

    def normal(shape, scale):
        return jax.random.normal(next(keys), shape, f32) * scale

    def gain(shape):
        return 1.0 + normal(shape, 0.02)

    n_idx = jnp.arange(SSM_STATE, dtype=f32)

    def lam_re():
        return -0.5 + normal((L, SSM_GROUPS, SSM_STATE), 0.01)

    def lam_im():
        return math.pi * n_idx + normal((L, SSM_GROUPS, SSM_STATE), 0.01)

    def log_dt():
        return jax.random.uniform(next(keys), (L, SSM_GROUPS), f32, math.log(DT_MIN), math.log(DT_MAX))

    b_scale = (2.0 * SSM_GROUP) ** -0.5
    c_scale = 0.5
    inp = {}
    inp['x'] = normal((BATCH, SEQ, D_MODEL), 1.0)
    inp['g_mix'] = gain((L, D_MODEL))
    inp['w_in'] = normal((L, D_MODEL, SSM_WIDTH + 3 * NA_WIDTH), D_MODEL ** -0.5)
    for tag in ('fwd', 'bwd'):
        inp['lam_re_' + tag] = lam_re()
        inp['lam_im_' + tag] = lam_im()
        inp['log_dt_' + tag] = log_dt()
        inp['b_re_' + tag] = normal((L, SSM_GROUPS, SSM_STATE, SSM_GROUP), b_scale)
        inp['b_im_' + tag] = normal((L, SSM_GROUPS, SSM_STATE, SSM_GROUP), b_scale)
        inp['c_re_' + tag] = normal((L, SSM_GROUPS, SSM_GROUP, SSM_STATE), c_scale)
        inp['c_im_' + tag] = normal((L, SSM_GROUPS, SSM_GROUP, SSM_STATE), c_scale)
    inp['ssm_d'] = normal((L, SSM_WIDTH), 1.0)
    inp['w_glu'] = normal((L, SSM_WIDTH, SSM_WIDTH), SSM_WIDTH ** -0.5)
    inp['b_glu'] = normal((L, SSM_WIDTH), 0.01)
    inp['na_rpb'] = normal((L, NA_HEADS, 2 * NA_KH_MAX - 1, 2 * NA_KW - 1), 0.1)
    inp['g_ssm_out'] = gain((L, SSM_WIDTH))
    inp['g_na_out'] = gain((L, NA_WIDTH))
    inp['w_out'] = normal((L, MIX_WIDTH, D_MODEL), MIX_WIDTH ** -0.5)
    inp['g_moe'] = gain((L, D_MODEL))
    inp['w_router'] = normal((L, D_MODEL, N_EXPERTS), D_MODEL ** -0.5)
    inp['b_router'] = normal((L, N_EXPERTS), 0.01)
    inp['w_gate'] = normal((L, N_EXPERTS, D_MODEL, D_FF), D_MODEL ** -0.5)
    inp['b_gate'] = normal((L, N_EXPERTS, D_FF), 0.01)
    inp['w_up'] = normal((L, N_EXPERTS, D_MODEL, D_FF), D_MODEL ** -0.5)
    inp['b_up'] = normal((L, N_EXPERTS, D_FF), 0.01)
    inp['w_down'] = normal((L, N_EXPERTS, D_FF, D_MODEL), D_FF ** -0.5)
    inp['b_down'] = normal((L, N_EXPERTS, D_MODEL), 0.01)
    inp['g_final'] = gain((D_MODEL,))
    return inp


def reference(x, g_mix, w_in,
              lam_re_fwd, lam_im_fwd, log_dt_fwd, b_re_fwd, b_im_fwd, c_re_fwd, c_im_fwd,
              lam_re_bwd, lam_im_bwd, log_dt_bwd, b_re_bwd, b_im_bwd, c_re_bwd, c_im_bwd,
              ssm_d, w_glu, b_glu, na_rpb, g_ssm_out, g_na_out, w_out,
              g_moe, w_router, b_router, w_gate, b_gate, w_up, b_up, w_down, b_down,
              g_final):
    bsz, l, _ = x.shape
    for i in range(DEPTH):
        h = rmsnorm(x, g_mix[i])
        proj = jnp.einsum('bld,de->ble', h, w_in[i])
        u, q, k, v = jnp.split(proj, [SSM_WIDTH, SSM_WIDTH + NA_WIDTH, SSM_WIDTH + 2 * NA_WIDTH], axis=-1)
        y_ssm = _s5_bidirectional(
            u,
            lam_re_fwd[i], lam_im_fwd[i], log_dt_fwd[i], b_re_fwd[i], b_im_fwd[i], c_re_fwd[i], c_im_fwd[i],
            lam_re_bwd[i], lam_im_bwd[i], log_dt_bwd[i], b_re_bwd[i], b_im_bwd[i], c_re_bwd[i], c_im_bwd[i],
            ssm_d[i], w_glu[i], b_glu[i])
        hd = (bsz, l, NA_HEADS, NA_HEAD_DIM)
        y_na = _neighbourhood_attention(q.reshape(hd), k.reshape(hd), v.reshape(hd), na_rpb[i])
        mixed = jnp.concatenate([rmsnorm(y_ssm, g_ssm_out[i]), rmsnorm(y_na, g_na_out[i])], axis=-1)
        x = x + jnp.einsum('ble,ed->bld', mixed, w_out[i])
        x = x + _moe(rmsnorm(x, g_moe[i]), w_router[i], b_router[i], w_gate[i], b_gate[i],
                     w_up[i], b_up[i], w_down[i], b_down[i])
    return rmsnorm(x, g_final)
```

```cpp
#include <hip/hip_runtime.h>
#include <cstdio>
#include <cstdint>
namespace pg8 {
#define PG8_LAS __attribute__((address_space(3)))
typedef unsigned short bf16_t;
typedef short bf16x8 __attribute__((ext_vector_type(8)));
typedef float f32x4 __attribute__((ext_vector_type(4)));
typedef unsigned u32x4 __attribute__((ext_vector_type(4)));
typedef float f32x2 __attribute__((ext_vector_type(2)));
typedef int i32x4 __attribute__((ext_vector_type(4)));
typedef int i32x8 __attribute__((ext_vector_type(8)));
constexpr int BM = 256, BK = 64, HALF = 128, HTB = HALF * BK * 2  , STAGE_BYTES = 8 * HTB;

__host__ __device__ __forceinline__ int lds_byte(int r, int c) { const int st = (r >> 4) * 2 + (c >> 5), rr = r & 15, cc = c & 31, ob = rr * 64 + cc * 2; return st * 1024 + (ob ^ (((ob >> 9) & 1) << 5)); }
__host__ __device__ __forceinline__ void stage_rc(int b, int& R, int& C) { const int st = b / 1024, sb = b % 1024, swz = sb ^ (((sb >> 9) & 1) << 5); R = (st >> 1) * 16 + swz / 64; C = (st & 1) * 32 + (swz % 64) / 2; }
__host__ __device__ __forceinline__ int perm32(int rho) { const int n = rho >> 4, i = rho & 15; return 8 * (i >> 2) + 4 * n + (i & 3); }

struct Unit { int pm, pn, aux, half, r0; const char* a; const char* b; };
struct Gemm { int K, lda, ldb; int kstepB = 0; };

__device__ __forceinline__ unsigned cvt_pk_bf16(float lo, float hi) { unsigned r; asm volatile("v_cvt_pk_bf16_f32 %0, %1, %2" : "=v"(r) : "v"(lo), "v"(hi)); return r; }

template <class Epi, class Sched, bool ALIGN_EPI = false, bool SP2 = false, bool FP8 = false, bool HALFU = false, bool GATHER = false>
__device__ __forceinline__ void gemm_phase(PG8_LAS unsigned char* lds, const Gemm g, const Sched& S, const Epi& E) {
    const int tid = threadIdx.x, wid = __builtin_amdgcn_readfirstlane(tid >> 6), lane = tid & 63, wr = wid >> 2, wc = wid & 3, fr = lane & 15, fq = lane >> 4;
    int Kop = g.K; asm volatile("" : "+s"(Kop));
    const int K = Kop, nt = K / BK;
    unsigned voffA[2], voffB[2];
#pragma unroll
    for (int i = 0; i < 2; ++i) { int R, C; stage_rc(tid * 16 + i * 8192, R, C); const int Rb = Epi::PERM ? ((R & ~31) + perm32(R & 31)) : R;
        voffA[i] = (unsigned)(R * g.lda + C) * 2u; voffB[i] = (unsigned)(Rb * g.ldb + C) * 2u; }
    const size_t kstep = (size_t)(BK * 2);
    const size_t kstepB = g.kstepB ? (size_t)g.kstepB : kstep;
    const size_t hstepA = (size_t)HALF * g.lda * 2, hstepB = (size_t)HALF * g.ldb * 2;
    const unsigned ldsw = (unsigned)wid * 1024u;
    const int aoff = lds_byte(wr * 64 + fr, fq * 8), boff = lds_byte(wc * 32 + fr, fq * 8);
#define PG8_SA(b, h) (((b) * 2 + (h)) * HTB)
#define PG8_SB(b, h) ((4 + (b) * 2 + (h)) * HTB)
#define PG8_STAGE(bufoff, gbase, voff) do { _Pragma("unroll") for (int _i = 0; _i < 2; ++_i) \
        __builtin_amdgcn_global_load_lds((const unsigned*)((const char*)(gbase) + (voff)[_i]), (PG8_LAS unsigned*)(lds + (bufoff) + ldsw + _i * 8192), 16, 0, 0); } while (0)
#define PG8_RD(off) (*(const PG8_LAS i32x4*)(lds + (off)))
#define PG8_STAGEG(bufoff, kb, GG) do { _Pragma("unroll") for (int _i = 0; _i < 2; ++_i) \
        __builtin_amdgcn_global_load_lds((const unsigned*)(S.A + (kb) + (GG)[_i]), (PG8_LAS unsigned*)(lds + (bufoff) + ldsw + _i * 8192), 16, 0, 0); } while (0)
#define PG8_FILLG(GG, idx) do { _Pragma("unroll") for (int _h = 0; _h < 2; ++_h) _Pragma("unroll") for (int _i = 0; _i < 2; ++_i) \
        GG[_h][_i] = (S.tokl[(idx) * 256 + _h * 128 + _i * 64 + gR0] & 8191u) * S.rowb + gC0; } while (0)
#define PG8_LDA(dst, b, h) do { if constexpr (FP8) { _Pragma("unroll") for (int m = 0; m < 4; ++m) dst##8[m] = __builtin_shufflevector(PG8_RD(PG8_SA(b, h) + aoff + m * 2048), PG8_RD(PG8_SA(b, h) + aoff + m * 2048 + 1024), 0, 1, 2, 3, 4, 5, 6, 7); } \
        else { _Pragma("unroll") for (int m = 0; m < 4; ++m) _Pragma("unroll") for (int k = 0; k < 2; ++k) dst[m][k] = *(const PG8_LAS bf16x8*)(lds + PG8_SA(b, h) + aoff + m * 2048 + k * 1024); } } while (0)
#define PG8_LDB(dst, b, h) do { if constexpr (FP8) { _Pragma("unroll") for (int n = 0; n < 2; ++n) dst##8[n] = __builtin_shufflevector(PG8_RD(PG8_SB(b, h) + boff + n * 2048), PG8_RD(PG8_SB(b, h) + boff + n * 2048 + 1024), 0, 1, 2, 3, 4, 5, 6, 7); } \
        else { _Pragma("unroll") for (int n = 0; n < 2; ++n) _Pragma("unroll") for (int k = 0; k < 2; ++k) dst[n][k] = *(const PG8_LAS bf16x8*)(lds + PG8_SB(b, h) + boff + n * 2048 + k * 1024); } } while (0)
#define PG8_MMA(ai, bj, At, Bt) do { __builtin_amdgcn_s_setprio(1); \
        if constexpr (FP8) { _Pragma("unroll") for (int m = 0; m < 4; ++m) _Pragma("unroll") for (int n = 0; n < 2; ++n) \
            asm volatile("v_mfma_scale_f32_16x16x128_f8f6f4 %0, %1, %2, %0, %3, %3 op_sel_hi:[0,0,0]" : "+v"(acc[ai][bj][m][n]) : "v"(Bt##8[n]), "v"(At##8[m]), "v"(scl)); } \
        else { _Pragma("unroll") for (int m = 0; m < 4; ++m) _Pragma("unroll") for (int n = 0; n < 2; ++n) _Pragma("unroll") for (int k = 0; k < 2; ++k) \
            acc[ai][bj][m][n] = __builtin_amdgcn_mfma_f32_16x16x32_bf16(Bt[n][k], At[m][k], acc[ai][bj][m][n], 0, 0, 0); } \
        __builtin_amdgcn_s_setprio(0); } while (0)
#define PG8_WAIT_V(n) asm volatile("s_waitcnt vmcnt(" #n ")" ::: "memory")
#define PG8_WAIT_L(n) asm volatile("s_waitcnt lgkmcnt(" #n ")" ::: "memory")
#define PG8_BAR __builtin_amdgcn_s_barrier()
#define PG8_SCHED __builtin_amdgcn_sched_barrier(0)
    Unit cur, nxt; int ui = 0;
    if (!S.next(0, cur)) return;
    int gR0 = 0; unsigned gC0 = 0u; unsigned gC[2][2], gN[2][2];
    if constexpr (GATHER) { int R, C; stage_rc(tid * 16, R, C); gR0 = R; gC0 = (unsigned)C * 2u; PG8_FILLG(gC, 0); }
    f32x4 acc[2][2][4][2];
#pragma unroll
    for (int a = 0; a < 2; ++a)
#pragma unroll
        for (int b = 0; b < 2; ++b)
#pragma unroll
            for (int m = 0; m < 4; ++m)
#pragma unroll
                for (int n = 0; n < 2; ++n) acc[a][b][m][n] = (f32x4){0.f, 0.f, 0.f, 0.f};
    bf16x8 At[4][2], B0[2][2], B1[2][2]; i32x8 At8[4], B08[2], B18[2];
    const int scl = 0x7f7f7f7f;
    const char* cA = cur.a; const char* cB = cur.b; bool hu = HALFU && cur.half != 0;
    S.a_ready(cur);
    if constexpr (SP2) {
        PG8_STAGE(PG8_SB(0, 0), cB, voffB); PG8_STAGE(PG8_SB(0, 1), cB + hstepB, voffB);
        if constexpr (GATHER) { PG8_STAGEG(PG8_SA(0, 0), 0, gC[0]); PG8_STAGEG(PG8_SA(0, 1), 0, gC[1]); } else { PG8_STAGE(PG8_SA(0, 0), cA, voffA); PG8_STAGE(PG8_SA(0, 1), cA + hstepA, voffA); }
        if (wr == 1) PG8_BAR;
        PG8_WAIT_V(2); PG8_BAR;
        PG8_STAGE(PG8_SB(1, 0), cB + kstepB, voffB); if constexpr (GATHER) PG8_STAGEG(PG8_SA(1, 0), kstep, gC[0]); else PG8_STAGE(PG8_SA(1, 0), cA + kstep, voffA); PG8_STAGE(PG8_SB(1, 1), cB + hstepB + kstepB, voffB);
        PG8_WAIT_V(6); PG8_BAR;
    } else {
        PG8_STAGE(PG8_SB(0, 0), cB, voffB); PG8_STAGE(PG8_SA(0, 0), cA, voffA); PG8_STAGE(PG8_SB(0, 1), cB + hstepB, voffB); PG8_STAGE(PG8_SA(0, 1), cA + hstepA, voffA);
        if (wr == 1) PG8_BAR;
        PG8_WAIT_V(4); PG8_BAR;
        PG8_STAGE(PG8_SB(1, 0), cB + kstepB, voffB); PG8_STAGE(PG8_SA(1, 0), cA + kstep, voffA); PG8_STAGE(PG8_SB(1, 1), cB + hstepB + kstepB, voffB);
        PG8_WAIT_V(6); PG8_BAR;
    }
    for (;;) {
        const bool has_next = S.next(ui + 1, nxt);
        const char* nA = has_next ? nxt.a : cA; const char* nB = has_next ? nxt.b : cB;
        if constexpr (GATHER) { if (has_next) PG8_FILLG(gN, ui + 1); else { gN[0][0] = gC[0][0]; gN[0][1] = gC[0][1]; gN[1][0] = gC[1][0]; gN[1][1] = gC[1][1]; } }
        for (int t = 0; t < nt; t += 2) {
            const bool last = (t == nt - 2);
            const char* a1 = cA + (size_t)(t + 1) * kstep;
            const char* a2 = last ? nA : cA + (size_t)(t + 2) * kstep; const char* b2 = last ? nB : cB + (size_t)(t + 2) * kstepB;
            const char* a3 = a2 + kstep; const char* b3 = b2 + kstepB;
            if (last && has_next) S.a_ready(nxt);
            if constexpr (Epi::MIDSCALE) { if (t == nt / 2) E.mid(acc, cur, wr, wc, fr, fq); }
            unsigned gs[2][2]; size_t k2 = 0;
            if constexpr (GATHER) { k2 = last ? 0 : (size_t)(t + 2) * kstep; gs[0][0] = last ? gN[0][0] : gC[0][0]; gs[0][1] = last ? gN[0][1] : gC[0][1]; gs[1][0] = last ? gN[1][0] : gC[1][0]; gs[1][1] = last ? gN[1][1] : gC[1][1]; }
            if constexpr (SP2) {
            PG8_LDB(B0, 0, 0); PG8_LDB(B1, 0, 1); PG8_SCHED; PG8_LDA(At, 0, 0); if constexpr (GATHER) PG8_STAGEG(PG8_SA(1, 1), (size_t)(t + 1) * kstep, gC[1]); else PG8_STAGE(PG8_SA(1, 1), a1 + hstepA, voffA);
            PG8_WAIT_V(8); PG8_WAIT_L(0); PG8_BAR; PG8_MMA(0, 0, At, B0); PG8_MMA(0, 1, At, B1); PG8_BAR; PG8_SCHED;
            if (!(HALFU && hu)) PG8_LDA(At, 0, 1); PG8_STAGE(PG8_SB(0, 0), b2, voffB); PG8_STAGE(PG8_SB(0, 1), b2 + hstepB, voffB); if constexpr (GATHER) PG8_STAGEG(PG8_SA(0, 0), k2, gs[0]); else PG8_STAGE(PG8_SA(0, 0), a2, voffA);
            PG8_WAIT_V(8); PG8_WAIT_L(0); PG8_BAR; if (!(HALFU && hu)) { PG8_MMA(1, 0, At, B0); PG8_MMA(1, 1, At, B1); } PG8_BAR; PG8_SCHED;
            PG8_LDB(B0, 1, 0); PG8_LDB(B1, 1, 1); PG8_SCHED; PG8_LDA(At, 1, 0); if constexpr (GATHER) PG8_STAGEG(PG8_SA(0, 1), k2, gs[1]); else PG8_STAGE(PG8_SA(0, 1), a2 + hstepA, voffA);
            PG8_WAIT_V(8); PG8_WAIT_L(0); PG8_BAR; PG8_MMA(0, 0, At, B0); PG8_MMA(0, 1, At, B1); PG8_BAR; PG8_SCHED;
            if (!(HALFU && hu)) PG8_LDA(At, 1, 1); PG8_STAGE(PG8_SB(1, 0), b3, voffB); PG8_STAGE(PG8_SB(1, 1), b3 + hstepB, voffB); if constexpr (GATHER) PG8_STAGEG(PG8_SA(1, 0), k2 + kstep, gs[0]); else PG8_STAGE(PG8_SA(1, 0), a3, voffA);
            PG8_WAIT_V(8); PG8_WAIT_L(0); PG8_BAR; if (!(HALFU && hu)) { PG8_MMA(1, 0, At, B0); PG8_MMA(1, 1, At, B1); } PG8_BAR; PG8_SCHED;
            } else {
            PG8_LDB(B0, 0, 0); PG8_SCHED; PG8_LDA(At, 0, 0); PG8_STAGE(PG8_SA(1, 1), a1 + hstepA, voffA);
            PG8_WAIT_L(8); PG8_BAR; PG8_WAIT_L(0); PG8_MMA(0, 0, At, B0); PG8_BAR; PG8_SCHED;
            PG8_LDB(B1, 0, 1); PG8_STAGE(PG8_SB(0, 0), b2, voffB);
            PG8_BAR; PG8_WAIT_L(0); PG8_MMA(0, 1, At, B1); PG8_BAR;
            PG8_LDA(At, 0, 1); PG8_STAGE(PG8_SA(0, 0), a2, voffA);
            PG8_BAR; PG8_WAIT_L(0); PG8_MMA(1, 0, At, B0); PG8_BAR; PG8_SCHED;
            PG8_STAGE(PG8_SB(0, 1), b2 + hstepB, voffB);
            PG8_WAIT_V(6); PG8_BAR; PG8_MMA(1, 1, At, B1); PG8_BAR;
            PG8_LDB(B0, 1, 0); PG8_SCHED; PG8_LDA(At, 1, 0); PG8_STAGE(PG8_SA(0, 1), a2 + hstepA, voffA);
            PG8_WAIT_L(8); PG8_BAR; PG8_WAIT_L(0); PG8_MMA(0, 0, At, B0); PG8_BAR; PG8_SCHED;
            PG8_LDB(B1, 1, 1); PG8_STAGE(PG8_SB(1, 0), b3, voffB);
            PG8_BAR; PG8_WAIT_L(0); PG8_MMA(0, 1, At, B1); PG8_BAR;
            PG8_LDA(At, 1, 1); PG8_STAGE(PG8_SA(1, 0), a3, voffA);
            PG8_BAR; PG8_WAIT_L(0); PG8_MMA(1, 0, At, B0); PG8_BAR; PG8_SCHED;
            PG8_STAGE(PG8_SB(1, 1), b3 + hstepB, voffB);
            PG8_WAIT_V(6); PG8_BAR; PG8_MMA(1, 1, At, B1); PG8_BAR;
            }
        }
        if constexpr (FP8) asm volatile("s_nop 15\n\ts_nop 15" ::: "memory");
        if constexpr (ALIGN_EPI) { if (wr == 0) PG8_BAR; }
        if constexpr (!Epi::AFTER_DRAIN) { E(acc, cur, wr, wc, fr, fq); S.done(cur); }
        if (!has_next) break;
#pragma unroll
        for (int a = 0; a < 2; ++a)
#pragma unroll
            for (int b = 0; b < 2; ++b)
#pragma unroll
                for (int m = 0; m < 4; ++m)
#pragma unroll
                    for (int n = 0; n < 2; ++n) acc[a][b][m][n] = (f32x4){0.f, 0.f, 0.f, 0.f};
        cur = nxt; cA = nA; cB = nB; ++ui; hu = HALFU && cur.half != 0;
        if constexpr (GATHER) { gC[0][0] = gN[0][0]; gC[0][1] = gN[0][1]; gC[1][0] = gN[1][0]; gC[1][1] = gN[1][1]; }
        if constexpr (ALIGN_EPI) { if (wr == 1) PG8_BAR; }
    }
    PG8_WAIT_V(0);
    if constexpr (!ALIGN_EPI) { if (wr == 0) PG8_BAR; }
    PG8_BAR;
    if constexpr (Epi::AFTER_DRAIN) { E.fused(acc, cur, wr, wc, fr, fq, lds, wid, lane); S.done(cur); }
#undef PG8_SA
#undef PG8_SB
#undef PG8_STAGE
#undef PG8_RD
#undef PG8_STAGEG
#undef PG8_FILLG
#undef PG8_LDA
#undef PG8_LDB
#undef PG8_MMA
#undef PG8_WAIT_V
#undef PG8_WAIT_L
#undef PG8_BAR
#undef PG8_SCHED
}

template <class Epi, class Sched>
__device__ __forceinline__ void gemm_phase_w32(PG8_LAS unsigned char* lds, const Gemm g, const Sched& S, const Epi& E) {
    const int tid = threadIdx.x, wid = __builtin_amdgcn_readfirstlane(tid >> 6), lane = tid & 63, wr = wid >> 2, wc = wid & 3, fr = lane & 15, fq = lane >> 4;
    int Kop = g.K; asm volatile("" : "+s"(Kop));
    const int K = Kop, nt = K / BK;
    unsigned voffA; { int R, C; stage_rc(tid * 16, R, C); voffA = (unsigned)(R * g.lda + C) * 2u; }
    const unsigned kstep = (unsigned)(BK * 2), hstepA = (unsigned)HALF * g.lda * 2u, qstepA = 64u * g.lda * 2u;
    const __amdgpu_buffer_rsrc_t rsA = S.rsrcA();
    const unsigned rowB = (unsigned)g.ldb * 4u, kstepB = (unsigned)BK * g.ldb * 4u;
    const __amdgpu_buffer_rsrc_t rsrc = S.rsrc(wid);
    const unsigned ldsw = (unsigned)wid * 1024u;
    const int aoff = lds_byte(wr * 64 + fr, fq * 8), boff = lds_byte(wc * 32 + fr, fq * 8);
    const int wq = (lane & 3) + 4 * (lane >> 5), kc = (lane >> 2) & 7, hh = wq & 1, wfq = wq >> 1;
    const unsigned voffW = (unsigned)((8 * kc) * g.ldb + 4 * wq) * 4u;
    const unsigned ldsW0 = (unsigned)(wr * HTB + lds_byte(wc * 32 + 16 * hh + 4 * wfq, 8 * kc)), h64 = (unsigned)hh * 64u;
#define PG8_SA(b, h) (((b) * 2 + (h)) * HTB)
#define PG8_SB(b, h) ((4 + (b) * 2 + (h)) * HTB)
#define PG8_STAGE(bufoff, goff, voff) do { _Pragma("unroll") for (int _i = 0; _i < 2; ++_i) \
        __builtin_amdgcn_raw_ptr_buffer_load_lds(rsA, (PG8_LAS void*)(lds + (bufoff) + ldsw + _i * 8192), 16, (voff), (goff) + _i * qstepA, 0, 0); } while (0)
#define PG8_LDA(dst, b, h) do { _Pragma("unroll") for (int m = 0; m < 4; ++m) _Pragma("unroll") for (int k = 0; k < 2; ++k) dst[m][k] = *(const PG8_LAS bf16x8*)(lds + PG8_SA(b, h) + aoff + m * 2048 + k * 1024); } while (0)
#define PG8_LDB(dst, b, h) do { _Pragma("unroll") for (int n = 0; n < 2; ++n) _Pragma("unroll") for (int k = 0; k < 2; ++k) dst[n][k] = *(const PG8_LAS bf16x8*)(lds + PG8_SB(b, h) + boff + n * 2048 + k * 1024); } while (0)
#define PG8_MMA(ai, bj, At, Bt) do { __builtin_amdgcn_s_setprio(1); _Pragma("unroll") for (int m = 0; m < 4; ++m) _Pragma("unroll") for (int n = 0; n < 2; ++n) _Pragma("unroll") for (int k = 0; k < 2; ++k) \
        acc[ai][bj][m][n] = __builtin_amdgcn_mfma_f32_16x16x32_bf16(Bt[n][k], At[m][k], acc[ai][bj][m][n], 0, 0, 0); __builtin_amdgcn_s_setprio(0); } while (0)
#define PG8_LOADB(wo) do { const unsigned o_ = (wo); _Pragma("unroll") for (int i_ = 0; i_ < 8; ++i_) rb[i_] = __builtin_bit_cast(f32x4, __builtin_amdgcn_raw_buffer_load_b128(rsrc, voffW, o_ + (unsigned)i_ * rowB, 0)); } while (0)
#define PG8_WRITEB(b) do { _Pragma("unroll") for (int j_ = 0; j_ < 4; ++j_) { u32x4 o_; o_.x = cvt_pk_bf16(rb[0][j_], rb[1][j_]); o_.y = cvt_pk_bf16(rb[2][j_], rb[3][j_]); o_.z = cvt_pk_bf16(rb[4][j_], rb[5][j_]); o_.w = cvt_pk_bf16(rb[6][j_], rb[7][j_]); \
        *(PG8_LAS u32x4*)(lds + PG8_SB(b, 0) + ldsW0 + ((h64 + 64u * j_) & 192u)) = o_; } } while (0)
#define PG8_WAIT_V(n) asm volatile("s_waitcnt vmcnt(" #n ")" ::: "memory")
#define PG8_WAIT_L(n) asm volatile("s_waitcnt lgkmcnt(" #n ")" ::: "memory")
#define PG8_BAR __builtin_amdgcn_s_barrier()
#define PG8_SCHED __builtin_amdgcn_sched_barrier(0)
    Unit cur, nxt; int ui = 0;
    if (!S.next(0, cur)) return;
    f32x4 acc[2][2][4][2];
#pragma unroll
    for (int a = 0; a < 2; ++a)
#pragma unroll
        for (int b = 0; b < 2; ++b)
#pragma unroll
            for (int m = 0; m < 4; ++m)
#pragma unroll
                for (int n = 0; n < 2; ++n) acc[a][b][m][n] = (f32x4){0.f, 0.f, 0.f, 0.f};
    bf16x8 At[4][2], B0[2][2], B1[2][2];
    f32x4 rb[8];
    unsigned cA = S.aoff(cur); unsigned cW = S.woff(cur, wid);
    PG8_LOADB(cW); PG8_STAGE(PG8_SA(0, 0), cA, voffA); PG8_STAGE(PG8_SA(0, 1), cA + hstepA, voffA);
    PG8_WRITEB(0);
    PG8_LOADB(cW + kstepB); PG8_STAGE(PG8_SA(1, 0), cA + kstep, voffA);
    PG8_WAIT_V(10); PG8_WAIT_L(0); PG8_BAR;
    if (wr == 1) PG8_BAR;
    for (;;) {
        const bool has_next = S.next(ui + 1, nxt);
        const unsigned nA = has_next ? S.aoff(nxt) : cA; const unsigned nW = has_next ? S.woff(nxt, wid) : cW;
        for (int t = 0; t < nt; t += 2) {
            const bool last = (t == nt - 2);
            const unsigned a1 = cA + (unsigned)(t + 1) * kstep;
            const unsigned a2 = last ? nA : cA + (unsigned)(t + 2) * kstep; const unsigned w2 = last ? nW : cW + (unsigned)(t + 2) * kstepB;
            const unsigned a3 = a2 + kstep; const unsigned w3 = w2 + kstepB;
            PG8_LDB(B0, 0, 0); PG8_LDB(B1, 0, 1); PG8_SCHED; PG8_LDA(At, 0, 0); PG8_STAGE(PG8_SA(1, 1), a1 + hstepA, voffA);
            PG8_WAIT_V(12); PG8_WAIT_L(0); PG8_BAR; PG8_MMA(0, 0, At, B0); PG8_MMA(0, 1, At, B1); PG8_BAR; PG8_SCHED;
            PG8_LDA(At, 0, 1); PG8_WRITEB(1); PG8_LOADB(w2); PG8_STAGE(PG8_SA(0, 0), a2, voffA);
            PG8_WAIT_V(12); PG8_WAIT_L(0); PG8_BAR; PG8_MMA(1, 0, At, B0); PG8_MMA(1, 1, At, B1); PG8_BAR; PG8_SCHED;
            PG8_LDB(B0, 1, 0); PG8_LDB(B1, 1, 1); PG8_SCHED; PG8_LDA(At, 1, 0); PG8_STAGE(PG8_SA(0, 1), a2 + hstepA, voffA);
            PG8_WAIT_V(12); PG8_WAIT_L(0); PG8_BAR; PG8_MMA(0, 0, At, B0); PG8_MMA(0, 1, At, B1); PG8_BAR; PG8_SCHED;
            PG8_LDA(At, 1, 1); PG8_WRITEB(0); PG8_LOADB(w3); PG8_STAGE(PG8_SA(1, 0), a3, voffA);
            PG8_WAIT_V(12); PG8_WAIT_L(0); PG8_BAR; PG8_MMA(1, 0, At, B0); PG8_MMA(1, 1, At, B1); PG8_BAR; PG8_SCHED;
        }
        if (wr == 0) PG8_BAR;
        E(acc, cur, wr, wc, fr, fq);
        if (!has_next) break;
#pragma unroll
        for (int a = 0; a < 2; ++a)
#pragma unroll
            for (int b = 0; b < 2; ++b)
#pragma unroll
                for (int m = 0; m < 4; ++m)
#pragma unroll
                    for (int n = 0; n < 2; ++n) acc[a][b][m][n] = (f32x4){0.f, 0.f, 0.f, 0.f};
        cur = nxt; cA = nA; cW = nW; ++ui;
        if (wr == 1) PG8_BAR;
    }
    PG8_WAIT_V(0);
    asm volatile("" :: "v"(rb[0]), "v"(rb[1]), "v"(rb[2]), "v"(rb[3]), "v"(rb[4]), "v"(rb[5]), "v"(rb[6]), "v"(rb[7]));
    PG8_BAR;
#undef PG8_SA
#undef PG8_SB
#undef PG8_STAGE
#undef PG8_LDA
#undef PG8_LDB
#undef PG8_MMA
#undef PG8_LOADB
#undef PG8_WRITEB
#undef PG8_WAIT_V
#undef PG8_WAIT_L
#undef PG8_BAR
#undef PG8_SCHED
}
}

constexpr int NWAVES = 8;
constexpr int SEQ = 8192, DM = 2048, NPROJ = 4096, SW = 1024, NG = 64, NE = 32, DFF = 2048;
constexpr int MPAD = 40960;
constexpr float RMS_EPS = 1e-5f;
constexpr int NPHASE = 13;
#ifndef MOE_MODE
#define MOE_MODE 2
#endif
#ifndef MK_N_LAUNCHES
#define MK_N_LAUNCHES 1
#endif
constexpr int N_LAUNCHES = MK_N_LAUNCHES;

constexpr size_t MiB = 1u << 20;
constexpr size_t WS_CTL = 0, CTL_ZERO_BYTES = 1 * MiB;
constexpr size_t WS_GW = 1 * MiB;
constexpr size_t WS_RE = 2 * MiB, WS_RR = WS_RE + 128 * 1024, WS_RG = WS_RE + 256 * 1024, WS_POS = WS_RE + 384 * 1024, WS_ROWGATE = WS_RE + 512 * 1024;
constexpr size_t WS_WTIN = 4 * MiB, WS_WTGLU = 20 * MiB, WS_WTOUT = 22 * MiB, WS_MS = 30 * MiB, WS_MCAT = 38 * MiB;
constexpr size_t WS_XN = 54 * MiB, WS_Q = 86 * MiB, WS_K = 102 * MiB, WS_V = 118 * MiB, WS_S5S = 134 * MiB, WS_ACAT = 166 * MiB;
constexpr size_t WS_YG = 198 * MiB, WS_YSSM = 214 * MiB, WS_YNA = 230 * MiB, WS_MIXED = 246 * MiB, WS_X2 = 278 * MiB;
constexpr size_t WS_XS = 342 * MiB, WS_ACT = 502 * MiB, WS_YS = 662 * MiB, WS_WTGU = 822 * MiB, WS_WTDN = 1334 * MiB, WS_END = 1590 * MiB;
constexpr int INVCAP = 8448;
constexpr size_t WS_INVT = WS_XS, WS_INVG = WS_XS + 2 * MiB;
constexpr int CW_SSQ = 32768;
constexpr int CW_BAR2 = 20480;
constexpr int CW_TMO = 0, CW_BAR = 4096, CW_CNT = 8192, CW_Q = 12288;

constexpr int RING_OFF = 0, RING_BYTES = 131072;
constexpr int LDS_BYTES = 147456;
constexpr int MISC_OFF = LDS_BYTES - 1024;

#define GAS __attribute__((address_space(1)))
#define LAS __attribute__((address_space(3)))
typedef unsigned short bf16;
typedef unsigned v4u __attribute__((ext_vector_type(4)));
typedef unsigned v2u __attribute__((ext_vector_type(2)));
typedef float f32x4 __attribute__((ext_vector_type(4)));
typedef float f32x2 __attribute__((ext_vector_type(2)));
typedef short bf16x8 __attribute__((ext_vector_type(8)));
typedef short bf16x4 __attribute__((ext_vector_type(4)));
typedef GAS unsigned gu32;
#define RLX_AGENT __ATOMIC_RELAXED, __HIP_MEMORY_SCOPE_AGENT
#define LDS_WAIT() asm volatile("s_waitcnt lgkmcnt(0)" ::: "memory")
#define VM_WAIT() asm volatile("s_waitcnt vmcnt(0)" ::: "memory")
__device__ __forceinline__ unsigned pk2(float lo, float hi) { return pg8::cvt_pk_bf16(lo, hi); }
__device__ __forceinline__ unsigned pk8(float a, float b, float c, float d) { int w = 0; w = __builtin_amdgcn_cvt_pk_fp8_f32(a, b, w, false); w = __builtin_amdgcn_cvt_pk_fp8_f32(c, d, w, true); return (unsigned)w; }
__device__ __forceinline__ float bf_lo(unsigned w) { return __uint_as_float(w << 16); }
__device__ __forceinline__ float bf_hi(unsigned w) { return __uint_as_float(w & 0xffff0000u); }
__device__ __forceinline__ float sigmoidf_(float x) { return __builtin_amdgcn_rcpf(1.0f + __builtin_amdgcn_exp2f(-1.4426950408889634f * x)); }
__device__ __forceinline__ float gelu_tanh(float x) { const float u = 0.7978845608028654f * (x + 0.044715f * x * x * x); const float e = __builtin_amdgcn_exp2f(2.885390081777927f * u); return x * (1.0f - __builtin_amdgcn_rcpf(e + 1.0f)); }

#define XB_TMO      128
#define XB_XCNT(j)  (256  + 64 * (j))
#define XB_XSUB(j)  (1280 + 64 * (j))
#define XB_XGEN(j)  (2304 + 64 * (j))
#define XB_TOP      3328
#define XB_TOPGEN   3392
#define XCD_BAR_WORDS 3456
#define XB_SPIN_CAP (1u << 18)
__device__ __forceinline__ unsigned xb_ld(unsigned* p)              { return __hip_atomic_load(p, __ATOMIC_RELAXED, __HIP_MEMORY_SCOPE_AGENT); }
__device__ __forceinline__ unsigned xb_add(unsigned* p, unsigned v) { return __hip_atomic_fetch_add(p, v, __ATOMIC_RELAXED, __HIP_MEMORY_SCOPE_AGENT); }
__device__ __forceinline__ unsigned xb_xcc_id() { return (unsigned)__builtin_amdgcn_s_getreg((3 << 11) | 20) & 0xFu; }
#define XB_SPIN(cond, bar) do { unsigned _sp = 0; while (cond) { __builtin_amdgcn_s_sleep(1); \
    if ((++_sp & 255u) == 0u) { if (xb_ld(&(bar)[XB_TMO])) break; if (_sp > XB_SPIN_CAP) { atomicAdd(&(bar)[XB_TMO], 1u); break; } } } } while (0)
struct XcdBarrier { unsigned* bar; unsigned x; volatile LAS unsigned* st; unsigned npart; };
__device__ __forceinline__ XcdBarrier xcd_barrier_post(unsigned* bar, volatile LAS unsigned* st, unsigned npart) {
    XcdBarrier b; b.bar = bar; b.x = xb_xcc_id(); b.st = st; b.npart = npart;
    if (threadIdx.x == 0) (void)xb_add(&bar[XB_XCNT(b.x)], 1u);
    return b;
}
__device__ __forceinline__ void xcd_barrier_complete(unsigned* bar, unsigned x, unsigned G, unsigned& nloc, unsigned& nx) {
    unsigned sum, cnt, mine, sp = 0u;
    for (;;) {
        sum = 0u; cnt = 0u; mine = 0u;
#pragma unroll
        for (unsigned j = 0; j < 16; ++j) { const unsigned c = xb_ld(&bar[XB_XCNT(j)]); sum += c; cnt += (c > 0u) ? 1u : 0u; mine = (j == x) ? c : mine; }
        if (sum == G) break;
        __builtin_amdgcn_s_sleep(1);
        if ((++sp & 255u) == 0u) { if (xb_ld(&bar[XB_TMO])) break; if (sp > XB_SPIN_CAP) { atomicAdd(&bar[XB_TMO], 1u); break; } }
    }
    nloc = mine > 0u ? mine : 1u; nx = cnt > 0u ? cnt : 1u;
}
__device__ __forceinline__ void xcd_barrier(const XcdBarrier& b) {
    asm volatile("s_waitcnt vmcnt(0)" ::: "memory");
    __syncthreads();
    if (threadIdx.x == 0) {
        unsigned* bar = b.bar;
        __builtin_amdgcn_s_waitcnt(0);
        unsigned nloc = b.st[0], nx = b.st[1];
        if (nloc == 0u) { xcd_barrier_complete(bar, b.x, b.npart, nloc, nx); b.st[0] = nloc; b.st[1] = nx; }
        const unsigned old = xb_add(&bar[XB_XSUB(b.x)], 1u);
        const unsigned gen = old / nloc;
        if (old + 1u == (gen + 1u) * nloc) {
            __builtin_amdgcn_fence(__ATOMIC_RELEASE, "agent");
            asm volatile("s_waitcnt vmcnt(0)" ::: "memory");
            const unsigned og = xb_add(&bar[XB_TOP], 1u);
            const unsigned tg = og / nx;
            if (og + 1u == (tg + 1u) * nx) xb_add(&bar[XB_TOPGEN], 1u);
            else XB_SPIN(xb_ld(&bar[XB_TOPGEN]) == tg, bar);
            __builtin_amdgcn_fence(__ATOMIC_ACQUIRE, "agent");
            xb_add(&bar[XB_XGEN(b.x)], 1u);
            asm volatile("s_waitcnt vmcnt(0)" ::: "memory");
        } else {
            XB_SPIN(xb_ld(&bar[XB_XGEN(b.x)]) == gen, bar);
            __builtin_amdgcn_fence(__ATOMIC_ACQUIRE, "agent");
            asm volatile("s_waitcnt vmcnt(0)" ::: "memory");
        }
    }
    __syncthreads();
}

struct Args { const float* in[34]; float* out; unsigned char* ws; int ph_lo, ph_hi; };
struct Frame {
    LAS unsigned char* lds;
    volatile LAS unsigned* MISC;
    gu32* ctl;
    unsigned char* ws;
    float* out;
    int tid, lane, wave, vcu, G;
};
__device__ __forceinline__ float wave_sum(float v) {
#pragma unroll
    for (int o = 1; o < 64; o <<= 1) v += __shfl_xor(v, o);
    return v;
}
__device__ __forceinline__ float wave_max(float v) {
#pragma unroll
    for (int o = 1; o < 64; o <<= 1) v = fmaxf(v, __shfl_xor(v, o));
    return v;
}

struct DenseOrder {
    const char* A; const char* Bt; size_t tstepA, tstepB; int nM, nN, nwg, G, c;
    __device__ void init(const void* A_, const void* Bt_, int M, int N, int lda, int ldb, int G_, int c_) { A = (const char*)A_; Bt = (const char*)Bt_; tstepA = (size_t)256 * lda * 2; tstepB = (size_t)256 * ldb * 2; nM = M / 256; nN = N / 256; nwg = nM * nN; G = G_; c = c_; }
    __device__ bool next(int i, pg8::Unit& u) const {
        const long L = (long)i * G + c; if (L >= nwg) return false;
        int wgid = (int)L; { const int q = nwg / 8, r = nwg % 8, xcd = wgid % 8, off = wgid / 8; wgid = (xcd < r ? xcd * (q + 1) : r * (q + 1) + (xcd - r) * q) + off; }
        const int nig = 8 * nN, gid = wgid / nig, fm = gid * 8, gsz = (nM - fm) < 8 ? (nM - fm) : 8;
        u.pm = fm + ((wgid % nig) % gsz); u.pn = (wgid % nig) / gsz; u.aux = 0; u.half = 0; u.r0 = 0; u.a = A + (size_t)u.pm * tstepA; u.b = Bt + (size_t)u.pn * tstepB; return true;
    }
    __device__ __forceinline__ void a_ready(const pg8::Unit&) const {}
    __device__ __forceinline__ void done(const pg8::Unit&) const {}
};
struct GroupOrder {
    const char* A; const char* Bt; size_t gstepA, gstepB, tstepA; int G, c;
    __device__ bool next(int i, pg8::Unit& u) const {
        const int L = i * G + c; if (L >= 128) return false;
        u.aux = L >> 1; u.pm = L & 1; u.pn = 0; u.half = 0; u.r0 = 0; u.a = A + (size_t)u.aux * gstepA + (size_t)u.pm * tstepA; u.b = Bt + (size_t)u.aux * gstepB; return true;
    }
    __device__ __forceinline__ void a_ready(const pg8::Unit&) const {}
    __device__ __forceinline__ void done(const pg8::Unit&) const {}
};
struct MoeOrder {
    const char* A; const char* Bt; size_t tstepA, tstepB, estepB; const LAS int* ul; const LAS unsigned* tokl; unsigned rowb;
    __device__ bool next(int i, pg8::Unit& u) const {
        if (i >= 12) return false; const int v = ul[4 * i], eh = ul[4 * i + 1]; if (!(v & 1)) return false;
        u.aux = eh & 255; u.half = eh >> 8; u.pm = ul[4 * i + 2]; u.pn = v >> 8; u.r0 = ul[4 * i + 3];
        u.a = A + (size_t)u.pm * tstepA; u.b = Bt + (size_t)u.aux * estepB + (size_t)u.pn * tstepB; return true;
    }
    __device__ __forceinline__ void a_ready(const pg8::Unit&) const {}
    __device__ __forceinline__ void done(const pg8::Unit&) const {}
};
__device__ __forceinline__ void moe_units(LAS int* ul, const volatile LAS unsigned* tc, int NT, int G, int c, int tid) {
    if (tid < 16) { const int L = tid * G + c; const int nfull = (int)tc[96 + 32] * NT, nh = (int)tc[129 + 32], total = nfull + nh * NT; int e = 0, pm = 0, pn = 0, hf = 0;
        if (L < nfull) {
            for (int k = 1; k < 32; ++k) { if (L >= (int)tc[96 + k] * NT) e = k; }
            const int f0 = (int)tc[96 + e], nmf = (int)tc[96 + e + 1] - f0, j = L - f0 * NT; pm = (int)tc[e] + j % nmf; pn = j / nmf;
        } else if (L < total) { const int Lh = L - nfull, hi = Lh % nh;
            for (int k = 1; k < 32; ++k) { if (hi >= (int)tc[129 + k]) e = k; }
            pm = (int)tc[e + 1] - 1; pn = Lh / nh; hf = 1; }
        ul[4 * tid] = (L < total ? 1 : 0) | (pn << 8); ul[4 * tid + 1] = e | (hf << 8); ul[4 * tid + 2] = pm; ul[4 * tid + 3] = (pm - (int)tc[e]) * 256; }
    __syncthreads();
}
struct MoeOrderW {
    const char* A; size_t tstepA; const float* W0; const float* W1; int updown; int NT, G, c; const volatile LAS unsigned* tc;
    __device__ bool next(int i, pg8::Unit& u) const {
        const int L = i * G + c; const int total = (int)tc[32] * NT; if (L >= total) return false;
        int e = 0;
#pragma unroll 1
        for (int k = 1; k < 32; ++k) { if (L >= (int)tc[k] * NT) e = k; }
        const int c0 = (int)tc[e], nm = (int)tc[e + 1] - c0, j = L - c0 * NT;
        u.aux = e; u.pm = c0 + j % nm; u.pn = j / nm; u.half = 0; u.r0 = 0; u.a = A + (size_t)u.pm * tstepA; u.b = nullptr; return true;
    }
    __device__ __forceinline__ __amdgpu_buffer_rsrc_t rsrcA() const { return __builtin_amdgcn_make_buffer_rsrc((void*)A, (short)0, MPAD * 2048 * 2, 0x00020000); }
    __device__ __forceinline__ unsigned aoff(const pg8::Unit& u) const { return (unsigned)u.pm * (unsigned)tstepA; }
    __device__ __forceinline__ __amdgpu_buffer_rsrc_t rsrc(int wid) const { return __builtin_amdgcn_make_buffer_rsrc((void*)((updown || wid < 4) ? W0 : W1), (short)0, 32 * 2048 * 2048 * 4, 0x00020000); }
    __device__ __forceinline__ unsigned woff(const pg8::Unit& u, int wid) const {
        return (unsigned)u.aux * (2048u * 2048u * 4u) + (updown ? (unsigned)(u.pn * 256 + wid * 32) : (unsigned)(u.pn * 128 + (wid & 3) * 32)) * 4u;
    }
};

#define EPI_LOOP_ROWS for (int ai = 0; ai < 2; ++ai) _Pragma("unroll") for (int m = 0; m < 4; ++m)
struct EpiInProj {
    static constexpr bool PERM = true, AFTER_DRAIN = false, MIDSCALE = false;
    bf16* acat; bf16* qkv;
    __device__ __forceinline__ void operator()(const f32x4 (&acc)[2][2][4][2], const pg8::Unit& u, int wr, int wc, int fr, int fq) const {
        const int t = u.pn >> 2; const float sc = (t == 1) ? 0.125f : 1.0f;
#pragma unroll
        EPI_LOOP_ROWS { const int row = u.pm * 256 + ai * 128 + wr * 64 + m * 16 + fr;
#pragma unroll
            for (int bj = 0; bj < 2; ++bj) { const int cr = (u.pn & 3) * 256 + bj * 128 + wc * 32 + 8 * fq;
                const f32x4 v0 = acc[ai][bj][m][0] * sc, v1 = acc[ai][bj][m][1] * sc;
                v4u w; w.x = pk2(v0[0], v0[1]); w.y = pk2(v0[2], v0[3]); w.z = pk2(v1[0], v1[1]); w.w = pk2(v1[2], v1[3]);
                if (t == 3) { bf16* vt = qkv + (size_t)2 * SEQ * 1024 + (size_t)cr * SEQ + row;
                    vt[0 * SEQ] = (bf16)(w.x & 0xffff); vt[1 * SEQ] = (bf16)(w.x >> 16); vt[2 * SEQ] = (bf16)(w.y & 0xffff); vt[3 * SEQ] = (bf16)(w.y >> 16);
                    vt[4 * SEQ] = (bf16)(w.z & 0xffff); vt[5 * SEQ] = (bf16)(w.z >> 16); vt[6 * SEQ] = (bf16)(w.w & 0xffff); vt[7 * SEQ] = (bf16)(w.w >> 16); }
                else { bf16* dst = (t == 0) ? acat + ((size_t)((cr >> 4) * 512 + (row >> 4)) * 512 + (row & 15) * 16 + (cr & 15))
                                     : qkv + (size_t)(t - 1) * SEQ * 1024 + (size_t)row * 1024 + cr;
                    *(v4u*)dst = w; } } }
    }
};
struct EpiS5S {
    static constexpr bool PERM = false, AFTER_DRAIN = false, MIDSCALE = false;
    float* S;
    __device__ __forceinline__ void operator()(const f32x4 (&acc)[2][2][4][2], const pg8::Unit& u, int wr, int wc, int fr, int fq) const {
#pragma unroll
        EPI_LOOP_ROWS { const int row = u.pm * 256 + ai * 128 + wr * 64 + m * 16 + fr; float* rp = S + ((size_t)u.aux * 512 + row) * 256 + wc * 32 + 4 * fq;
#pragma unroll
            for (int bj = 0; bj < 2; ++bj)
#pragma unroll
                for (int n = 0; n < 2; ++n) *(f32x4*)(rp + bj * 128 + n * 16) = acc[ai][bj][m][n]; }
    }
};
struct EpiS5Y {
    static constexpr bool PERM = true, AFTER_DRAIN = false, MIDSCALE = false;
    bf16* YG;
    __device__ __forceinline__ void operator()(const f32x4 (&acc)[2][2][4][2], const pg8::Unit& u, int wr, int wc, int fr, int fq) const {
#pragma unroll
        EPI_LOOP_ROWS { const int c = u.pm * 256 + ai * 128 + wr * 64 + m * 16 + fr;
#pragma unroll
            for (int bj = 0; bj < 2; ++bj) { const int n = bj * 128 + wc * 32 + 8 * fq; const int tok = c * 16 + (n >> 4);
                const f32x4 v0 = acc[ai][bj][m][0], v1 = acc[ai][bj][m][1];
                v4u w; w.x = pk2(gelu_tanh(v0[0]), gelu_tanh(v0[1])); w.y = pk2(gelu_tanh(v0[2]), gelu_tanh(v0[3])); w.z = pk2(gelu_tanh(v1[0]), gelu_tanh(v1[1])); w.w = pk2(gelu_tanh(v1[2]), gelu_tanh(v1[3]));
                *(v4u*)(YG + (size_t)tok * 1024 + u.aux * 16 + (n & 15)) = w; } }
    }
};
struct EpiGLU {
    static constexpr bool PERM = true, AFTER_DRAIN = false, MIDSCALE = false;
    const bf16* YG; const float* bias; bf16* O; float* ssq;
    __device__ __forceinline__ void operator()(const f32x4 (&acc)[2][2][4][2], const pg8::Unit& u, int wr, int wc, int fr, int fq) const {
        const int col0 = u.pn * 256 + wc * 32 + 8 * fq;
        const f32x4 bv[2][2] = {{*(const f32x4*)(bias + col0), *(const f32x4*)(bias + col0 + 4)}, {*(const f32x4*)(bias + col0 + 128), *(const f32x4*)(bias + col0 + 132)}};
#pragma unroll
        for (int ai = 0; ai < 2; ++ai) {
            v4u yv[4][2];
#pragma unroll
            for (int m = 0; m < 4; ++m)
#pragma unroll
                for (int bj = 0; bj < 2; ++bj) yv[m][bj] = *(const v4u*)(YG + (size_t)(u.pm * 256 + ai * 128 + wr * 64 + m * 16 + fr) * 1024 + col0 + bj * 128);
            asm volatile("" ::: "memory");
#pragma unroll
            for (int m = 0; m < 4; ++m) { const int row = u.pm * 256 + ai * 128 + wr * 64 + m * 16 + fr; float sq = 0.f;
#pragma unroll
                for (int bj = 0; bj < 2; ++bj) { const int col = col0 + bj * 128; const v4u y = yv[m][bj];
                    const f32x4 v0 = acc[ai][bj][m][0] + bv[bj][0], v1 = acc[ai][bj][m][1] + bv[bj][1];
                    const float o0 = bf_lo(y.x) * sigmoidf_(v0[0]), o1 = bf_hi(y.x) * sigmoidf_(v0[1]), o2 = bf_lo(y.y) * sigmoidf_(v0[2]), o3 = bf_hi(y.y) * sigmoidf_(v0[3]);
                    const float o4 = bf_lo(y.z) * sigmoidf_(v1[0]), o5 = bf_hi(y.z) * sigmoidf_(v1[1]), o6 = bf_lo(y.w) * sigmoidf_(v1[2]), o7 = bf_hi(y.w) * sigmoidf_(v1[3]);
                    sq += (o0 * o0 + o1 * o1) + (o2 * o2 + o3 * o3) + (o4 * o4 + o5 * o5) + (o6 * o6 + o7 * o7);
                    v4u w; w.x = pk2(o0, o1); w.y = pk2(o2, o3); w.z = pk2(o4, o5); w.w = pk2(o6, o7);
                    *(v4u*)(O + (size_t)row * 2048 + col) = w; }
                sq += __shfl_xor(sq, 16); sq += __shfl_xor(sq, 32);
                if (fq == 0) atomicAdd(ssq + 2 * row, sq); }
            asm volatile("" ::: "memory"); }
    }
};
struct EpiOut {
    static constexpr bool PERM = false, AFTER_DRAIN = false, MIDSCALE = true;
    const float* X; float* X2; const float* ssq;
    __device__ __forceinline__ void mid(f32x4 (&acc)[2][2][4][2], const pg8::Unit& u, int wr, int wc, int fr, int fq) const {
#pragma unroll
        EPI_LOOP_ROWS { const int row = u.pm * 256 + ai * 128 + wr * 64 + m * 16 + fr; const f32x2 q = *(const f32x2*)(ssq + 2 * row);
            const float ratio = sqrtf((q.y * (1.0f / 1024.0f) + RMS_EPS) / (q.x * (1.0f / 1024.0f) + RMS_EPS));
#pragma unroll
            for (int bj = 0; bj < 2; ++bj)
#pragma unroll
                for (int n = 0; n < 2; ++n) acc[ai][bj][m][n] = acc[ai][bj][m][n] * ratio; }
    }
    __device__ __forceinline__ void operator()(const f32x4 (&acc)[2][2][4][2], const pg8::Unit& u, int wr, int wc, int fr, int fq) const {
#pragma unroll
        for (int ai = 0; ai < 2; ++ai) {
            f32x4 xv[4][2][2]; float r2[4];
#pragma unroll
            for (int m = 0; m < 4; ++m) { const int row = u.pm * 256 + ai * 128 + wr * 64 + m * 16 + fr; const size_t off = (size_t)row * 2048 + u.pn * 256 + wc * 32 + 4 * fq;
                r2[m] = ssq[2 * row + 1];
#pragma unroll
                for (int bj = 0; bj < 2; ++bj)
#pragma unroll
                    for (int n = 0; n < 2; ++n) xv[m][bj][n] = *(const f32x4*)(X + off + bj * 128 + n * 16); }
            asm volatile("" ::: "memory");
#pragma unroll
            for (int m = 0; m < 4; ++m) { const int row = u.pm * 256 + ai * 128 + wr * 64 + m * 16 + fr; const size_t off = (size_t)row * 2048 + u.pn * 256 + wc * 32 + 4 * fq;
                const float rr = 1.0f / sqrtf(r2[m] * (1.0f / 1024.0f) + RMS_EPS);
#pragma unroll
                for (int bj = 0; bj < 2; ++bj)
#pragma unroll
                    for (int n = 0; n < 2; ++n) *(f32x4*)(X2 + off + bj * 128 + n * 16) = xv[m][bj][n] + acc[ai][bj][m][n] * rr; }
            asm volatile("" ::: "memory"); }
    }
};
struct EpiGateUp {
    static constexpr bool PERM = true, AFTER_DRAIN = false, MIDSCALE = false;
    const float* bg; const float* bu; bf16* ACT;
    __device__ __forceinline__ void operator()(const f32x4 (&acc)[2][2][4][2], const pg8::Unit& u, int wr, int wc, int fr, int fq) const {
        const int f0 = u.pn * 128 + wc * 32 + 8 * fq; const float* pg = bg + (size_t)u.aux * 2048 + f0; const float* pu = bu + (size_t)u.aux * 2048 + f0;
        const f32x4 g0 = *(const f32x4*)pg, g1 = *(const f32x4*)(pg + 4), u0 = *(const f32x4*)pu, u1 = *(const f32x4*)(pu + 4);
#pragma unroll
        EPI_LOOP_ROWS { const int row = u.pm * 256 + ai * 128 + wr * 64 + m * 16 + fr; float a[8];
#pragma unroll
            for (int n = 0; n < 2; ++n)
#pragma unroll
                for (int j = 0; j < 4; ++j) { const float g = fminf(acc[ai][0][m][n][j] + (n ? g1[j] : g0[j]), 7.0f); const float uu = fminf(fmaxf(acc[ai][1][m][n][j] + (n ? u1[j] : u0[j]), -7.0f), 7.0f);
                    a[n * 4 + j] = (uu + 1.0f) * (g * sigmoidf_(1.702f * g)); }
            v4u w; w.x = pk2(a[0], a[1]); w.y = pk2(a[2], a[3]); w.z = pk2(a[4], a[5]); w.w = pk2(a[6], a[7]);
            *(v4u*)(ACT + (size_t)row * 2048 + f0) = w; }
    }
};
struct EpiDown {
    static constexpr bool PERM = true, AFTER_DRAIN = false, MIDSCALE = false;
    const float* bd; const float* rowgate; bf16* YS;
    __device__ __forceinline__ void operator()(const f32x4 (&acc)[2][2][4][2], const pg8::Unit& u, int wr, int wc, int fr, int fq) const {
#pragma unroll
        EPI_LOOP_ROWS { const int row = u.pm * 256 + ai * 128 + wr * 64 + m * 16 + fr; const float rg = rowgate[row];
#pragma unroll
            for (int bj = 0; bj < 2; ++bj) { const int col = u.pn * 256 + bj * 128 + wc * 32 + 8 * fq; const float* pb = bd + (size_t)u.aux * 2048 + col;
                const f32x4 v0 = (acc[ai][bj][m][0] + *(const f32x4*)pb) * rg, v1 = (acc[ai][bj][m][1] + *(const f32x4*)(pb + 4)) * rg;
                v4u w; w.x = pk2(v0[0], v0[1]); w.y = pk2(v0[2], v0[3]); w.z = pk2(v1[0], v1[1]); w.w = pk2(v1[2], v1[3]);
                *(v4u*)(YS + (size_t)row * 2048 + col) = w; } }
    }
};

struct EpiGateUp8 {
    static constexpr bool PERM = true, AFTER_DRAIN = false, MIDSCALE = false;
    const float* bg; const float* bu; unsigned char* ACT;
    __device__ __forceinline__ void operator()(const f32x4 (&acc)[2][2][4][2], const pg8::Unit& u, int wr, int wc, int fr, int fq) const {
        const int f0 = u.pn * 128 + wc * 32 + 8 * fq; const float* pg = bg + (size_t)u.aux * 2048 + f0; const float* pu = bu + (size_t)u.aux * 2048 + f0;
        const f32x4 gbv[2] = {*(const f32x4*)pg, *(const f32x4*)(pg + 4)}, ubv[2] = {*(const f32x4*)pu, *(const f32x4*)(pu + 4)};
#pragma unroll
        EPI_LOOP_ROWS { if (u.half && ai == 1) continue; const int row = u.pm * 256 + ai * 128 + wr * 64 + m * 16 + fr; unsigned w[2];
#pragma unroll
            for (int n = 0; n < 2; ++n) { const f32x4 gb = gbv[n], ub = ubv[n]; float a[4];
#pragma unroll
                for (int j = 0; j < 4; j += 2) {
                    const f32x2 ag = {acc[ai][0][m][n][j], acc[ai][0][m][n][j + 1]}, au = {acc[ai][1][m][n][j], acc[ai][1][m][n][j + 1]};
                    f32x2 g = ag * 0.015625f + (f32x2){gb[j], gb[j + 1]}, uu = au * 0.015625f + (f32x2){ub[j], ub[j + 1]};
                    g.x = fminf(g.x, 7.0f); g.y = fminf(g.y, 7.0f); uu.x = fminf(fmaxf(uu.x, -7.0f), 7.0f); uu.y = fminf(fmaxf(uu.y, -7.0f), 7.0f);
                    const f32x2 t = g * (-1.702f * 1.4426950408889634f); f32x2 e = {__builtin_amdgcn_exp2f(t.x), __builtin_amdgcn_exp2f(t.y)}; e = e + 1.0f;
                    const f32x2 r = {__builtin_amdgcn_rcpf(e.x), __builtin_amdgcn_rcpf(e.y)};
                    const f32x2 o = (uu + 1.0f) * (g * r); a[j] = o.x; a[j + 1] = o.y; }
                w[n] = pk8(a[0], a[1], a[2], a[3]); }
            v2u o; o.x = w[0]; o.y = w[1];
            *(v2u*)(ACT + (size_t)row * 2048 + f0) = o;
            asm volatile("" ::: "memory"); }
    }
};
struct EpiDown8 {
    static constexpr bool PERM = true, AFTER_DRAIN = false, MIDSCALE = false;
    const float* bd; const float* rowgate; unsigned char* YS;
    __device__ __forceinline__ void operator()(const f32x4 (&acc)[2][2][4][2], const pg8::Unit& u, int wr, int wc, int fr, int fq) const {
        const int col0 = u.pn * 256 + wc * 32 + 8 * fq; const float* pb = bd + (size_t)u.aux * 2048 + col0;
        const f32x4 bv[2][2] = {{*(const f32x4*)pb, *(const f32x4*)(pb + 4)}, {*(const f32x4*)(pb + 128), *(const f32x4*)(pb + 132)}};
        float rgv[2][4];
#pragma unroll
        for (int ai = 0; ai < 2; ++ai)
#pragma unroll
            for (int m = 0; m < 4; ++m) rgv[ai][m] = rowgate[u.aux * INVCAP + u.r0 + ai * 128 + wr * 64 + m * 16 + fr] * 16.0f;
        asm volatile("" ::: "memory");
#pragma unroll
        EPI_LOOP_ROWS { if (u.half && ai == 1) continue; const int lr = ai * 128 + wr * 64 + m * 16 + fr; const int row = u.pm * 256 + lr; const float rg = rgv[ai][m];
#pragma unroll
            for (int bj = 0; bj < 2; ++bj) { const int col = col0 + bj * 128;
                const f32x4 v0 = (acc[ai][bj][m][0] * 0.015625f + bv[bj][0]) * rg, v1 = (acc[ai][bj][m][1] * 0.015625f + bv[bj][1]) * rg;
                v2u w; w.x = pk8(v0[0], v0[1], v0[2], v0[3]); w.y = pk8(v1[0], v1[1], v1[2], v1[3]);
                *(v2u*)(YS + (size_t)row * 2048 + col) = w; } }
    }
};
struct EpiGateUpW {
    const float* bg; const float* bu; bf16* ACT;
    __device__ __forceinline__ void operator()(const f32x4 (&acc)[2][2][4][2], const pg8::Unit& u, int wr, int wc, int fr, int fq) const {
        const int f0 = u.pn * 128 + wc * 32 + 8 * fq; const float* pg = bg + (size_t)u.aux * 2048 + f0; const float* pu = bu + (size_t)u.aux * 2048 + f0;
#pragma unroll
        EPI_LOOP_ROWS { const int row = u.pm * 256 + ai * 128 + wr * 64 + m * 16 + fr; unsigned w[4];
#pragma unroll
            for (int n = 0; n < 2; ++n) { const f32x4 gb = *(const f32x4*)(pg + 4 * n), ub = *(const f32x4*)(pu + 4 * n); float a[4];
#pragma unroll
                for (int j = 0; j < 4; ++j) { const int rg = n ? ((j + 1) & 3) : j;
                    const float g = fminf(acc[ai][0][m][n][rg] + gb[j], 7.0f); const float uu = fminf(fmaxf(acc[ai][1][m][n][rg] + ub[j], -7.0f), 7.0f);
                    a[j] = (uu + 1.0f) * (g * sigmoidf_(1.702f * g)); }
                w[2 * n] = pk2(a[0], a[1]); w[2 * n + 1] = pk2(a[2], a[3]); }
            v4u o; o.x = w[0]; o.y = w[1]; o.z = w[2]; o.w = w[3];
            *(v4u*)(ACT + (size_t)row * 2048 + f0) = o;
            asm volatile("" ::: "memory"); }
    }
};
struct EpiDownW {
    const float* bd; const float* rowgate; bf16* YS;
    __device__ __forceinline__ void operator()(const f32x4 (&acc)[2][2][4][2], const pg8::Unit& u, int wr, int wc, int fr, int fq) const {
#pragma unroll
        EPI_LOOP_ROWS { const int row = u.pm * 256 + ai * 128 + wr * 64 + m * 16 + fr; const float rg = rowgate[row];
#pragma unroll
            for (int bj = 0; bj < 2; ++bj) { const int col = u.pn * 256 + bj * 128 + wc * 32 + 8 * fq; const float* pb = bd + (size_t)u.aux * 2048 + col;
                const f32x4 b0 = *(const f32x4*)pb, b1 = *(const f32x4*)(pb + 4); const f32x4 a0 = acc[ai][bj][m][0], a1 = acc[ai][bj][m][1];
                const f32x4 v0 = (a0 + b0) * rg, v1 = ((f32x4){a1[1], a1[2], a1[3], a1[0]} + b1) * rg;
                v4u w; w.x = pk2(v0[0], v0[1]); w.y = pk2(v0[2], v0[3]); w.z = pk2(v1[0], v1[1]); w.w = pk2(v1[2], v1[3]);
                *(v4u*)(YS + (size_t)row * 2048 + col) = w; } }
    }
};
__device__ __forceinline__ void tr_item(const float* __restrict__ W, int N, bf16* __restrict__ WT, int Kp, int k0, int n0, int drow0, int lane, const float* __restrict__ gk = nullptr) {
    const int nq = lane & 15, kb = lane >> 4;
    const float* src = W + (size_t)(k0 + kb * 16) * N + n0 + 4 * nq;
    f32x4 v[16];
#pragma unroll
    for (int i = 0; i < 16; ++i) { v[i] = *(const f32x4*)(src + (size_t)i * N); if (gk) v[i] = v[i] * gk[k0 + kb * 16 + i]; }
#pragma unroll
    for (int j = 0; j < 4; ++j) {
        v4u lo, hi;
        lo.x = pk2(v[0][j], v[1][j]); lo.y = pk2(v[2][j], v[3][j]); lo.z = pk2(v[4][j], v[5][j]); lo.w = pk2(v[6][j], v[7][j]);
        hi.x = pk2(v[8][j], v[9][j]); hi.y = pk2(v[10][j], v[11][j]); hi.z = pk2(v[12][j], v[13][j]); hi.w = pk2(v[14][j], v[15][j]);
        bf16* dst = WT + (size_t)(drow0 + 4 * nq + j) * Kp + k0 + kb * 16;
        *(v4u*)dst = lo; *(v4u*)(dst + 8) = hi;
    }
}
__device__ __forceinline__ void tr_item8(const float* __restrict__ W, int N, unsigned char* __restrict__ WT, int Kp, int k0, int n0, int drow0, int lane) {
    const int nq = lane & 7, kb = lane >> 3;
    const float* src = W + (size_t)(k0 + kb * 16) * N + n0 + 4 * nq;
    f32x4 v[16];
#pragma unroll
    for (int i = 0; i < 16; ++i) v[i] = __builtin_nontemporal_load((const f32x4*)(src + (size_t)i * N)) * 64.0f;
#pragma unroll
    for (int j = 0; j < 4; ++j) {
        v4u o; o.x = pk8(v[0][j], v[1][j], v[2][j], v[3][j]); o.y = pk8(v[4][j], v[5][j], v[6][j], v[7][j]); o.z = pk8(v[8][j], v[9][j], v[10][j], v[11][j]); o.w = pk8(v[12][j], v[13][j], v[14][j], v[15][j]);
        *(v4u*)(WT + (size_t)(drow0 + 4 * nq + j) * Kp + k0 + kb * 16) = o;
    }
}
__device__ __forceinline__ void rms_row_to_fp8(const float* __restrict__ xrow, const float* __restrict__ g, unsigned char* __restrict__ orow, int lane) {
    f32x4 v[8]; float s = 0.f;
#pragma unroll
    for (int j = 0; j < 8; ++j) { v[j] = *(const f32x4*)(xrow + 4 * lane + 256 * j); s += (v[j].x * v[j].x + v[j].y * v[j].y) + (v[j].z * v[j].z + v[j].w * v[j].w); }
    const float rstd = 1.0f / sqrtf(wave_sum(s) * (1.0f / 2048.0f) + RMS_EPS);
#pragma unroll
    for (int j = 0; j < 8; ++j) { const f32x4 gg = *(const f32x4*)(g + 4 * lane + 256 * j);
        *(unsigned*)(orow + 4 * lane + 256 * j) = pk8(v[j].x * rstd * gg.x, v[j].y * rstd * gg.y, v[j].z * rstd * gg.z, v[j].w * rstd * gg.w); }
}
__device__ __forceinline__ void rms_row_to_bf16(const float* __restrict__ xrow, const float* __restrict__ g, bf16* __restrict__ orow, int lane) {
    f32x4 v[8]; float s = 0.f;
#pragma unroll
    for (int j = 0; j < 8; ++j) { v[j] = *(const f32x4*)(xrow + 4 * lane + 256 * j); s += (v[j].x * v[j].x + v[j].y * v[j].y) + (v[j].z * v[j].z + v[j].w * v[j].w); }
    const float rstd = 1.0f / sqrtf(wave_sum(s) * (1.0f / 2048.0f) + RMS_EPS);
#pragma unroll
    for (int j = 0; j < 8; ++j) { const f32x4 gg = *(const f32x4*)(g + 4 * lane + 256 * j); v2u o; o.x = pk2(v[j].x * rstd * gg.x, v[j].y * rstd * gg.y); o.y = pk2(v[j].z * rstd * gg.z, v[j].w * rstd * gg.w);
        *(v2u*)(orow + 4 * lane + 256 * j) = o; }
}
__device__ __forceinline__ void s5_precompute(Frame& F, const Args& args, int g) {
    LAS f32x2* pw = (LAS f32x2*)(F.lds);
    LAS f32x2* bb = (LAS f32x2*)(F.lds + 17408);
    LAS f32x2* cc = (LAS f32x2*)(F.lds + 33792);
    LAS float* Kt = (LAS float*)(F.lds + 50176);
    const int tid = F.tid;
    if (tid < 128) {
        const int dir = tid >> 6, p = tid & 63;
        const float* LRE = dir ? args.in[10] : args.in[3]; const float* LIM = dir ? args.in[11] : args.in[4]; const float* LDT = dir ? args.in[12] : args.in[5];
        const float* BRE = dir ? args.in[13] : args.in[6]; const float* BIM = dir ? args.in[14] : args.in[7]; const float* CRE = dir ? args.in[15] : args.in[8]; const float* CIM = dir ? args.in[16] : args.in[9];
        const float lre = fminf(LRE[g * 64 + p], -1e-4f), lim = LIM[g * 64 + p], dt = expf(LDT[g]);
        const float mag = expf(lre * dt), ang = lim * dt; const float lbr = mag * cosf(ang), lbi = mag * sinf(ang);
        float pr = 1.f, pi = 0.f;
#pragma unroll 1
        for (int m = 0; m <= 16; ++m) { pw[(dir * 17 + m) * 64 + p] = (f32x2){pr, pi}; const float nr = pr * lbr - pi * lbi, ni = pr * lbi + pi * lbr; pr = nr; pi = ni; }
        const float nr = lbr - 1.0f, ni = lbi, den = lre * lre + lim * lim; const float cr = (nr * lre + ni * lim) / den, ci = (ni * lre - nr * lim) / den;
#pragma unroll 4
        for (int ch = 0; ch < 16; ++ch) { const float br = BRE[(size_t)(g * 64 + p) * 16 + ch], bi = BIM[(size_t)(g * 64 + p) * 16 + ch];
            bb[(dir * 64 + p) * 16 + ch] = (f32x2){cr * br - ci * bi, cr * bi + ci * br}; }
#pragma unroll 4
        for (int o = 0; o < 16; ++o) cc[(dir * 16 + o) * 64 + p] = (f32x2){CRE[(size_t)(g * 16 + o) * 64 + p], CIM[(size_t)(g * 16 + o) * 64 + p]};
    }
    __syncthreads();
#pragma unroll 1
    for (int it = 0; it < 16; ++it) { const int idx = tid + 512 * it; const int dir = idx >> 12, m = (idx >> 8) & 15, o = (idx >> 4) & 15, ch = idx & 15; float s = 0.f;
#pragma unroll 4
        for (int p = 0; p < 64; ++p) { const f32x2 c = cc[(dir * 16 + o) * 64 + p], w = pw[(dir * 17 + m) * 64 + p], b = bb[(dir * 64 + p) * 16 + ch];
            const float tr = c.x * w.x - c.y * w.y, ti = c.x * w.y + c.y * w.x; s += tr * b.x - ti * b.y; }
        Kt[idx] = s; }
    __syncthreads();
    bf16* Ms = (bf16*)(F.ws + WS_MS) + (size_t)g * 256 * 256; bf16* Mc = (bf16*)(F.ws + WS_MCAT) + (size_t)g * 256 * 512;
#pragma unroll 1
    for (int it = 0; it < 16; ++it) { const int q = tid + 512 * it; const int n = q >> 5, k0 = (q & 31) * 8; const int ip = k0 >> 4, ch0 = k0 & 15, dirn = n >> 7, ri = (n >> 6) & 1, p = n & 63; const int e = dirn == 0 ? 15 - ip : ip;
        const f32x2 w = pw[(dirn * 17 + e) * 64 + p]; float val[8];
#pragma unroll
        for (int j = 0; j < 8; ++j) { const f32x2 b = bb[(dirn * 64 + p) * 16 + ch0 + j]; val[j] = ri == 0 ? (w.x * b.x - w.y * b.y) : (w.x * b.y + w.y * b.x); }
        v4u o; o.x = pk2(val[0], val[1]); o.y = pk2(val[2], val[3]); o.z = pk2(val[4], val[5]); o.w = pk2(val[6], val[7]);
        *(v4u*)(Ms + (size_t)n * 256 + k0) = o; }
    const float* dvec = args.in[17];
#pragma unroll 1
    for (int it = 0; it < 32; ++it) { const int q = tid + 512 * it; const int n = q >> 6, k0 = (q & 63) * 8; const int i = n >> 4, o = n & 15; float val[8];
        if (k0 < 256) { const int ip = k0 >> 4, ch0 = k0 & 15;
#pragma unroll
            for (int j = 0; j < 8; ++j) { const int ch = ch0 + j; float v = 0.f;
                if (ip <= i) v += Kt[((0 * 16 + (i - ip)) * 16 + o) * 16 + ch];
                if (ip >= i) v += Kt[((1 * 16 + (ip - i)) * 16 + o) * 16 + ch];
                if (ip == i && ch == o) v += dvec[g * 16 + o];
                val[j] = v; }
        } else { const int kk = k0 - 256, sect = kk >> 6, p0 = kk & 63, dirn = sect >> 1; const int mm = dirn == 0 ? i + 1 : 16 - i;
#pragma unroll
            for (int j = 0; j < 8; ++j) { const int p = p0 + j; const f32x2 c = cc[(dirn * 16 + o) * 64 + p], w = pw[(dirn * 17 + mm) * 64 + p];
                val[j] = (sect & 1) ? -(c.x * w.y + c.y * w.x) : (c.x * w.x - c.y * w.y); } }
        v4u ov; ov.x = pk2(val[0], val[1]); ov.y = pk2(val[2], val[3]); ov.z = pk2(val[4], val[5]); ov.w = pk2(val[6], val[7]);
        *(v4u*)(Mc + (size_t)n * 512 + k0) = ov; }
    __syncthreads();
}
constexpr int I_IN = 32 * 64, I_GLU = 16 * 16, I_OUT = 32 * 32, I_E = 32 * 32;
constexpr int NITEMS2 = I_GLU + I_OUT + (MOE_MODE == 1 ? 0 : NE * 3 * I_E);
__device__ __forceinline__ void conv_item(Frame& F, const Args& args, int r) {
    if (r < I_GLU) { const int kb = r >> 4, nb = r & 15; tr_item(args.in[18], SW, (bf16*)(F.ws + WS_WTGLU), SW, kb * 64, nb * 64, nb * 64, F.lane); return; } r -= I_GLU;
    if (r < I_OUT) { const int kb = r >> 5, nb = r & 31; tr_item(args.in[23], DM, (bf16*)(F.ws + WS_WTOUT), DM, kb * 64, nb * 64, nb * 64, F.lane, (kb < 16 ? args.in[21] : args.in[22] - 1024)); return; } r -= I_OUT;
    const int e = r / (3 * I_E), r2 = r % (3 * I_E), which = r2 / I_E, r3 = r2 % I_E;
#if MOE_MODE == 2
    const int k0 = (r3 >> 6) * 128, n0 = (r3 & 63) * 32;
    if (which == 0) tr_item8(args.in[27] + (size_t)e * DM * DFF, DFF, (unsigned char*)(F.ws + WS_WTGU) + (size_t)e * 4096 * DM, DM, k0, n0, (n0 >> 7) * 256 + (n0 & 127), F.lane);
    else if (which == 1) tr_item8(args.in[29] + (size_t)e * DM * DFF, DFF, (unsigned char*)(F.ws + WS_WTGU) + (size_t)e * 4096 * DM, DM, k0, n0, (n0 >> 7) * 256 + 128 + (n0 & 127), F.lane);
    else tr_item8(args.in[31] + (size_t)e * DFF * DM, DM, (unsigned char*)(F.ws + WS_WTDN) + (size_t)e * DM * DFF, DFF, k0, n0, n0, F.lane);
#else
    const int kb = r3 >> 5, nb = r3 & 31, n0 = nb * 64;
    if (which == 0) tr_item(args.in[27] + (size_t)e * DM * DFF, DFF, (bf16*)(F.ws + WS_WTGU) + (size_t)e * 4096 * DM, DM, kb * 64, n0, (n0 >> 7) * 256 + (n0 & 127), F.lane);
    else if (which == 1) tr_item(args.in[29] + (size_t)e * DM * DFF, DFF, (bf16*)(F.ws + WS_WTGU) + (size_t)e * 4096 * DM, DM, kb * 64, n0, (n0 >> 7) * 256 + 128 + (n0 & 127), F.lane);
    else tr_item(args.in[31] + (size_t)e * DFF * DM, DM, (bf16*)(F.ws + WS_WTDN) + (size_t)e * DM * DFF, DFF, kb * 64, n0, n0, F.lane);
#endif
}
#if MOE_MODE == 2
__device__ __forceinline__ void moe_item_addr(Frame& F, int r, int& which, unsigned& soff, unsigned char*& dst) {
    const int e = r / (3 * I_E), r2 = r % (3 * I_E); which = r2 / I_E; const int r3 = r2 % I_E; const int k0 = (r3 >> 6) * 128, n0 = (r3 & 63) * 32; const int nq = F.lane & 7, kb = F.lane >> 3;
    unsigned char* WT = which == 2 ? (unsigned char*)(F.ws + WS_WTDN) + (size_t)e * DM * DFF : (unsigned char*)(F.ws + WS_WTGU) + (size_t)e * 4096 * DM;
    const int drow0 = which == 2 ? n0 : (n0 >> 7) * 256 + (which == 1 ? 128 : 0) + (n0 & 127);
    soff = (unsigned)e * (unsigned)(DM * DFF * 4) + (unsigned)((k0 + kb * 16) * DFF + n0 + 4 * nq) * 4u; dst = WT + (size_t)(k0 >> 7) * (size_t)((which == 2 ? DM : 4096) * 128) + (size_t)(drow0 + 4 * nq) * 128 + kb * 16;
}
__device__ __forceinline__ v4u cv_rsrc(const float* p) { const unsigned long long a = (unsigned long long)p; return (v4u){(unsigned)a, (unsigned)(a >> 32) & 0xffffu, (unsigned)(NE * DM * DFF * 4), 0x00020000u}; }
#define CV8_LOAD(v, rs, so) do { _Pragma("unroll") for (int i_ = 0; i_ < 16; ++i_) v[i_] = __builtin_bit_cast(f32x4, __builtin_amdgcn_raw_buffer_load_b128((rs), (so), i_ * (DFF * 4), 2)); } while (0)
#define CV8_STORE(v, dst) do { _Pragma("unroll") for (int j_ = 0; j_ < 4; ++j_) { v4u o_; o_.x = pk8(v[0][j_] * 64.f, v[1][j_] * 64.f, v[2][j_] * 64.f, v[3][j_] * 64.f); o_.y = pk8(v[4][j_] * 64.f, v[5][j_] * 64.f, v[6][j_] * 64.f, v[7][j_] * 64.f); \
        o_.z = pk8(v[8][j_] * 64.f, v[9][j_] * 64.f, v[10][j_] * 64.f, v[11][j_] * 64.f); o_.w = pk8(v[12][j_] * 64.f, v[13][j_] * 64.f, v[14][j_] * 64.f, v[15][j_] * 64.f); *(v4u*)((dst) + (size_t)j_ * 128) = o_; } } while (0)
#endif
__device__ __forceinline__ void conv_queue(Frame& F, const Args& args) {
    for (;;) { int base = 0; if (F.lane == 0) base = (int)__hip_atomic_fetch_add((unsigned*)(F.ctl + CW_Q), 8u, RLX_AGENT);
        base = __builtin_amdgcn_readfirstlane(base); if (base >= NITEMS2) break;
#if MOE_MODE == 2
        if (base >= I_GLU + I_OUT) {
            const v4u r0 = cv_rsrc(args.in[27]), r1 = cv_rsrc(args.in[29]), r2 = cv_rsrc(args.in[31]);
            int wa, wb; unsigned sa, sb; unsigned char* da; unsigned char* db; f32x4 va[16], vb[16];
#define CVA_LOAD(v, w, so) do { const v4u rs_ = (w) == 0 ? r0 : ((w) == 1 ? r1 : r2); \
        _Pragma("unroll") for (int i_ = 0; i_ < 16; ++i_) asm volatile("s_nop 4\n\tbuffer_load_dwordx4 %0, %1, %2, 0 offen nt" : "=&v"(v[i_]) : "v"((so) + (unsigned)(i_ * (DFF * 4))), "s"(rs_) : "memory"); } while (0)
#define CVA_WAIT(v, N) do { asm volatile("s_waitcnt vmcnt(" #N ")" : "+v"(v[0]), "+v"(v[1]), "+v"(v[2]), "+v"(v[3]), "+v"(v[4]), "+v"(v[5]), "+v"(v[6]), "+v"(v[7]) : : "memory"); \
        asm volatile("" : "+v"(v[8]), "+v"(v[9]), "+v"(v[10]), "+v"(v[11]), "+v"(v[12]), "+v"(v[13]), "+v"(v[14]), "+v"(v[15]) : : "memory"); } while (0)
            moe_item_addr(F, base - (I_GLU + I_OUT), wa, sa, da); CVA_LOAD(va, wa, sa);
#pragma unroll
            for (int i = 0; i < 8; i += 2) {
                moe_item_addr(F, base + i + 1 - (I_GLU + I_OUT), wb, sb, db); CVA_LOAD(vb, wb, sb);
                if (i == 0) CVA_WAIT(va, 16); else CVA_WAIT(va, 20);
                CV8_STORE(va, da);
                if (i + 2 < 8) { moe_item_addr(F, base + i + 2 - (I_GLU + I_OUT), wa, sa, da); CVA_LOAD(va, wa, sa); CVA_WAIT(vb, 20); } else CVA_WAIT(vb, 4);
                CV8_STORE(vb, db); }
#undef CVA_LOAD
#undef CVA_WAIT
            continue; }
#endif
#pragma unroll 1
        for (int i = 0; i < 8; ++i) if (base + i < NITEMS2) conv_item(F, args, base + i); }
}
__device__ __forceinline__ void p0_prologue(Frame& F, const Args& args) {
    const int gw = F.vcu * NWAVES + F.wave, NGW = F.G * NWAVES;
    for (int m = gw; m < SEQ; m += NGW) rms_row_to_bf16(args.in[0] + (size_t)m * DM, args.in[1], (bf16*)(F.ws + WS_XN) + (size_t)m * DM, F.lane);
    for (int i = gw * 64 + F.lane; i < DM * NE; i += NGW * 64) ((float*)(F.ws + WS_GW))[i] = args.in[24][i & 2047] * args.in[25][(size_t)(i & 2047) * 32 + (i >> 11)];
    for (int r = gw; r < I_IN; r += NGW) { const int kb = r >> 6, nb = r & 63; tr_item(args.in[2], NPROJ, (bf16*)(F.ws + WS_WTIN), DM, kb * 64, nb * 64, nb * 64, F.lane); }
}

constexpr int NA_VOFF = 65536, NA_RPOFF = 131072, NA_MGOFF = 133120;
__device__ __forceinline__ void na_task(Frame& F, const Args& args, int h, int rb) {
    LAS unsigned char* L = F.lds; LAS float* rp = (LAS float*)(F.lds + NA_RPOFF);
    const bf16* Qb = (const bf16*)(F.ws + WS_Q); const bf16* Kb = (const bf16*)(F.ws + WS_K); const bf16* Vb = (const bf16*)(F.ws + WS_V); bf16* Yb = (bf16*)(F.ws + WS_MIXED) + 1024; float* ssq = (float*)(F.ctl + CW_SSQ);
    const int tid = F.tid, lane = F.lane, fr = lane & 15, fq = lane >> 4, qt = F.wave & 3, kh = F.wave >> 2;
    const int r0 = rb * 8;
    const int kcS = tid >> 3, cS = tid & 7, dS = tid >> 3;
    const unsigned kdst = (unsigned)(kcS * 128 + ((cS ^ ((kcS >> 1) & 7)) << 4));
    const unsigned vdstb = (unsigned)(NA_VOFF + dS * 1024);
    const bf16* ksrc = Kb + (size_t)kcS * 1024 + h * 64 + cS * 8; const bf16* vsrc = Vb + (size_t)(h * 64 + dS) * SEQ + cS * 8;
    __syncthreads();
    { const int rs0 = r0 < 4 ? 0 : (r0 > 124 ? 120 : r0 - 4);
#pragma unroll 4
      for (int j = 0; j < 8; ++j) { const int ra = rs0 + j, slot = ra & 7;
          *(LAS v4u*)(L + slot * 8192 + kdst) = *(const v4u*)(ksrc + (size_t)ra * 64 * 1024);
          *(LAS v4u*)(L + vdstb + (((unsigned)(slot * 16 + 2 * cS) ^ (unsigned)((dS & 15) << 1)) << 3)) = *(const v4u*)(vsrc + ra * 64); } }
    for (int i = tid; i < 480; i += 512) rp[i] = ((i & 31) < 31) ? args.in[20][(size_t)h * 465 + (i >> 5) * 31 + (i & 31)] : -3.0e38f;
    __syncthreads();
    const int ct0 = qt == 0 ? 0 : (qt == 3 ? 1 : qt - 1);
    const int cq = qt * 16 + fr;
    const int cs = cq < 8 ? 0 : (cq > 56 ? 48 : cq - 8);
    unsigned dcb[3][4];
#pragma unroll
    for (int ct = 0; ct < 3; ++ct)
#pragma unroll
        for (int j = 0; j < 4; ++j) { const int kcc = (ct0 + ct) * 16 + fq * 4 + j; const bool valid = (kcc >= cs) && (kcc < cs + 16);
            int dc = kcc - cq; dc = dc < -15 ? -15 : (dc > 15 ? 15 : dc); dc += 15; dcb[ct][j] = valid ? (unsigned)dc * 4u : 124u; }
    bf16x8 qf[2];
#pragma unroll
    for (int ks = 0; ks < 2; ++ks) qf[ks] = *(const bf16x8*)(Qb + (size_t)(r0 * 64 + cq) * 1024 + h * 64 + ks * 32 + fq * 8);
#pragma unroll 1
    for (int st = 0; st < 8; ++st) {
        const int r = r0 + st; const int rs = r < 4 ? 0 : (r > 124 ? 120 : r - 4);
        const int rn = r + 1; const int rsn = rn < 4 ? 0 : (rn > 124 ? 120 : rn - 4); const bool pre = (st < 7) && (rsn != rs);
        v4u pk = {0u, 0u, 0u, 0u}, pv = {0u, 0u, 0u, 0u};
        if (pre) { const int ra = rsn + 7; pk = *(const v4u*)(ksrc + (size_t)ra * 64 * 1024); pv = *(const v4u*)(vsrc + ra * 64); }
        bf16x8 qn[2];
#pragma unroll
        for (int ks = 0; ks < 2; ++ks) qn[ks] = *(const bf16x8*)(Qb + (size_t)((st < 7 ? r + 1 : r) * 64 + cq) * 1024 + h * 64 + ks * 32 + fq * 8);
        f32x4 o[4] = {(f32x4){0.f, 0.f, 0.f, 0.f}, (f32x4){0.f, 0.f, 0.f, 0.f}, (f32x4){0.f, 0.f, 0.f, 0.f}, (f32x4){0.f, 0.f, 0.f, 0.f}};
        float mrun = -3.0e38f, lrun = 0.f;
#pragma unroll
        for (int kpi = 0; kpi < 2; ++kpi) { const int kp = kh * 2 + kpi;
            f32x4 sc[2][3], bs[2][3]; float mx = mrun;
#pragma unroll
            for (int k2 = 0; k2 < 2; ++k2) { const LAS unsigned char* rowp = (const LAS unsigned char*)rp + (rs + kp * 2 + k2 - r + 7) * 128;
#pragma unroll
                for (int ct = 0; ct < 3; ++ct)
#pragma unroll
                    for (int j = 0; j < 4; ++j) bs[k2][ct][j] = *(const LAS float*)(rowp + dcb[ct][j]); }
#pragma unroll
            for (int k2 = 0; k2 < 2; ++k2)
#pragma unroll
                for (int ct = 0; ct < 3; ++ct) {
                    const int kra = rs + kp * 2 + k2, slot = kra & 7; const int kc = (ct0 + ct) * 16 + fr;
                    const LAS unsigned char* kb = L + slot * 8192 + kc * 128; const int sw = (kc >> 1) & 7;
                    const bf16x8 k0 = *(const LAS bf16x8*)(kb + ((fq ^ sw) << 4)), k1 = *(const LAS bf16x8*)(kb + (((4 + fq) ^ sw) << 4));
                    f32x4 a = {0.f, 0.f, 0.f, 0.f};
                    a = __builtin_amdgcn_mfma_f32_16x16x32_bf16(k0, qf[0], a, 0, 0, 0);
                    a = __builtin_amdgcn_mfma_f32_16x16x32_bf16(k1, qf[1], a, 0, 0, 0);
                    a = a + bs[k2][ct];
                    mx = fmaxf(fmaxf(mx, fmaxf(a[0], a[1])), fmaxf(a[2], a[3]));
                    sc[k2][ct] = a; }
            mx = fmaxf(mx, __shfl_xor(mx, 16)); mx = fmaxf(mx, __shfl_xor(mx, 32));
            const float alpha = __expf(mrun - mx);
            float sum = 0.f;
#pragma unroll
            for (int k2 = 0; k2 < 2; ++k2)
#pragma unroll
                for (int ct = 0; ct < 3; ++ct)
#pragma unroll
                    for (int j = 0; j < 4; ++j) { const float p = __expf(sc[k2][ct][j] - mx); sc[k2][ct][j] = p; sum += p; }
            sum += __shfl_xor(sum, 16); sum += __shfl_xor(sum, 32);
            lrun = lrun * alpha + sum; mrun = mx;
            o[0] = o[0] * alpha; o[1] = o[1] * alpha; o[2] = o[2] * alpha; o[3] = o[3] * alpha;
#pragma unroll
            for (int pr = 0; pr < 3; ++pr) {
                const int ta = 2 * pr, tb = 2 * pr + 1; const int k2a = ta / 3, cta = ta % 3, k2b = tb / 3, ctb = tb % 3;
                const f32x4 pa = sc[k2a][cta], pb = sc[k2b][ctb];
                v4u pw; pw.x = pk2(pa[0], pa[1]); pw.y = pk2(pa[2], pa[3]); pw.z = pk2(pb[0], pb[1]); pw.w = pk2(pb[2], pb[3]);
                const bf16x8 pf = __builtin_bit_cast(bf16x8, pw);
                const unsigned cha = (unsigned)((((rs + kp * 2 + k2a) & 7) * 64 + (ct0 + cta) * 16 + fq * 4) >> 2), chb = (unsigned)((((rs + kp * 2 + k2b) & 7) * 64 + (ct0 + ctb) * 16 + fq * 4) >> 2);
#pragma unroll
                for (int d2 = 0; d2 < 4; ++d2) { const LAS unsigned char* vr = L + NA_VOFF + (d2 * 16 + fr) * 1024; const unsigned sx = (unsigned)(fr << 1);
                    const v2u va = *(const LAS v2u*)(vr + ((cha ^ sx) << 3)), vb = *(const LAS v2u*)(vr + ((chb ^ sx) << 3));
                    v4u vw; vw.x = va.x; vw.y = va.y; vw.z = vb.x; vw.w = vb.y;
                    o[d2] = __builtin_amdgcn_mfma_f32_16x16x32_bf16(__builtin_bit_cast(bf16x8, vw), pf, o[d2], 0, 0, 0); } }
        }
        LAS unsigned char* mg = L + NA_MGOFF + qt * 2176;
        if (kh == 1) {
#pragma unroll
            for (int d2 = 0; d2 < 4; ++d2) { v2u w; w.x = pk2(o[d2][0], o[d2][1]); w.y = pk2(o[d2][2], o[d2][3]); *(LAS v2u*)(mg + (d2 * 64 + lane) * 8) = w; }
            if (fq == 0) { *(LAS float*)(mg + 2048 + fr * 8) = mrun; *(LAS float*)(mg + 2048 + fr * 8 + 4) = lrun; }
        }
        qf[0] = qn[0]; qf[1] = qn[1];
        __syncthreads();
        if (kh == 0) {
            const float m1 = *(const LAS float*)(mg + 2048 + fr * 8), l1 = *(const LAS float*)(mg + 2048 + fr * 8 + 4);
            const float mm = fmaxf(mrun, m1), e0 = __expf(mrun - mm), e1 = __expf(m1 - mm); const float inv = 1.0f / (lrun * e0 + l1 * e1);
            float sq = 0.f;
#pragma unroll
            for (int d2 = 0; d2 < 4; ++d2) { const v2u w1 = *(const LAS v2u*)(mg + (d2 * 64 + lane) * 8);
                const f32x4 o1 = {bf_lo(w1.x), bf_hi(w1.x), bf_lo(w1.y), bf_hi(w1.y)}; const f32x4 ov = (o[d2] * e0 + o1 * e1) * inv;
                sq += (ov[0] * ov[0] + ov[1] * ov[1]) + (ov[2] * ov[2] + ov[3] * ov[3]);
                v2u w; w.x = pk2(ov[0], ov[1]); w.y = pk2(ov[2], ov[3]);
                *(v2u*)(Yb + (size_t)(r * 64 + cq) * 2048 + h * 64 + d2 * 16 + fq * 4) = w; }
            sq += __shfl_xor(sq, 16); sq += __shfl_xor(sq, 32);
            if (fq == 0) atomicAdd(ssq + 2 * (r * 64 + cq) + 1, sq);
        }
        if (pre) { const int slot = (rsn + 7) & 7;
            *(LAS v4u*)(L + slot * 8192 + kdst) = pk;
            *(LAS v4u*)(L + vdstb + (((unsigned)(slot * 16 + 2 * cS) ^ (unsigned)((dS & 15) << 1)) << 3)) = pv; }
        __syncthreads();
    }
}

__device__ __forceinline__ void s5_scan(Frame& F, const Args& args, int g, int dir) {
    LAS f32x2* E = (LAS f32x2*)(F.lds);
    const int p = F.lane, w = F.wave;
    const float* LRE = dir ? args.in[10] : args.in[3]; const float* LIM = dir ? args.in[11] : args.in[4]; const float* LDT = dir ? args.in[12] : args.in[5];
    const float lre = fminf(LRE[g * 64 + p], -1e-4f), lim = LIM[g * 64 + p], dt = expf(LDT[g]);
    const float mag = expf(lre * dt), ang = lim * dt; float ar = mag * cosf(ang), ai = mag * sinf(ang);
#pragma unroll
    for (int k = 0; k < 4; ++k) { const float nr = ar * ar - ai * ai, ni = 2.f * ar * ai; ar = nr; ai = ni; }
    float br = ar, bi = ai;
#pragma unroll
    for (int k = 0; k < 6; ++k) { const float nr = br * br - bi * bi, ni = 2.f * br * bi; br = nr; bi = ni; }
    const float* S = (const float*)(F.ws + WS_S5S) + (size_t)g * 512 * 256 + dir * 128 + p;
    bf16* X = (bf16*)(F.ws + WS_ACAT) + (size_t)g * 512 * 512 + 256 + dir * 128 + p;
    const int c0 = w * 64;
    float sre[64], sim[64];
#pragma unroll
    for (int j = 0; j < 64; ++j) { const int c = dir == 0 ? c0 + j : c0 + 63 - j; sre[j] = S[(size_t)c * 256]; sim[j] = S[(size_t)c * 256 + 64]; }
    float xr = 0.f, xi = 0.f;
#pragma unroll
    for (int j = 0; j < 64; ++j) { const float nr = ar * xr - ai * xi + sre[j], ni = ar * xi + ai * xr + sim[j]; xr = nr; xi = ni; }
    __syncthreads();
    E[w * 64 + p] = (f32x2){xr, xi};
    __syncthreads();
    xr = 0.f; xi = 0.f;
    if (dir == 0) { for (int ww = 0; ww < w; ++ww) { const f32x2 e = E[ww * 64 + p]; const float nr = br * xr - bi * xi + e.x, ni = br * xi + bi * xr + e.y; xr = nr; xi = ni; } }
    else { for (int ww = 7; ww > w; --ww) { const f32x2 e = E[ww * 64 + p]; const float nr = br * xr - bi * xi + e.x, ni = br * xi + bi * xr + e.y; xr = nr; xi = ni; } }
#pragma unroll
    for (int j = 0; j < 64; ++j) { const int c = dir == 0 ? c0 + j : c0 + 63 - j;
        X[(size_t)c * 512] = (bf16)(pk2(xr, 0.f) & 0xffff); X[(size_t)c * 512 + 64] = (bf16)(pk2(xi, 0.f) & 0xffff);
        const float nr = ar * xr - ai * xi + sre[j], ni = ar * xi + ai * xr + sim[j]; xr = nr; xi = ni; }
}

__device__ __forceinline__ void mixed_row(Frame& F, const Args& args, int tok) {
    const int lane = F.lane;
#pragma unroll
    for (int half = 0; half < 2; ++half) {
        const bf16* src = (const bf16*)(F.ws + (half == 0 ? WS_YSSM : WS_YNA)) + (size_t)tok * 1024 + lane * 8; const float* g = (half == 0 ? args.in[21] : args.in[22]) + lane * 8;
        const v4u a = *(const v4u*)src, b = *(const v4u*)(src + 512);
        float v[16] = {bf_lo(a.x), bf_hi(a.x), bf_lo(a.y), bf_hi(a.y), bf_lo(a.z), bf_hi(a.z), bf_lo(a.w), bf_hi(a.w), bf_lo(b.x), bf_hi(b.x), bf_lo(b.y), bf_hi(b.y), bf_lo(b.z), bf_hi(b.z), bf_lo(b.w), bf_hi(b.w)};
        float s = 0.f;
#pragma unroll
        for (int j = 0; j < 16; ++j) s += v[j] * v[j];
        const float rstd = 1.0f / sqrtf(wave_sum(s) * (1.0f / 1024.0f) + RMS_EPS);
        bf16* dst = (bf16*)(F.ws + WS_MIXED) + (size_t)tok * 2048 + half * 1024 + lane * 8;
#pragma unroll
        for (int q = 0; q < 2; ++q) { const f32x4 g0 = *(const f32x4*)(g + q * 512), g1 = *(const f32x4*)(g + q * 512 + 4);
            v4u o; o.x = pk2(v[q * 8 + 0] * rstd * g0.x, v[q * 8 + 1] * rstd * g0.y); o.y = pk2(v[q * 8 + 2] * rstd * g0.z, v[q * 8 + 3] * rstd * g0.w);
            o.z = pk2(v[q * 8 + 4] * rstd * g1.x, v[q * 8 + 5] * rstd * g1.y); o.w = pk2(v[q * 8 + 6] * rstd * g1.z, v[q * 8 + 7] * rstd * g1.w);
            *(v4u*)(dst + q * 512) = o; }
    }
}

constexpr int RT_PX = 2068;
__device__ __forceinline__ void router_group(Frame& F, const Args& args, int tg) {
    LAS float* X = (LAS float*)(F.lds);
    LAS float* logit = (LAS float*)(F.lds + 16 * RT_PX * 4);
    LAS float* rstdv = logit + 32 * 33;
    const int lane = F.lane, w = F.wave, i = lane & 15, kq = lane >> 4; const int t0 = tg * 32;
    const float* gb = (const float*)(F.ws + WS_GW) + (size_t)i * DM + 256 * w + 4 * kq;
    f32x4 gg[8];
#pragma unroll
    for (int j = 0; j < 8; ++j) gg[j] = *(const f32x4*)(args.in[24] + 4 * lane + 256 * j);
    __syncthreads();
#pragma unroll 1
    for (int p = 0; p < 2; ++p) {
#pragma unroll
        for (int rr = 0; rr < 2; ++rr) { const int r = 2 * w + rr, tok = t0 + 16 * p + r;
            const float* xrow = (const float*)(F.ws + WS_X2) + (size_t)tok * DM; f32x4 v[8]; float ss = 0.f;
#pragma unroll
            for (int j = 0; j < 8; ++j) { v[j] = *(const f32x4*)(xrow + 4 * lane + 256 * j); ss += (v[j].x * v[j].x + v[j].y * v[j].y) + (v[j].z * v[j].z + v[j].w * v[j].w); }
#pragma unroll
            for (int j = 0; j < 8; ++j) *(LAS f32x4*)(X + r * RT_PX + 4 * lane + 256 * j) = v[j];
            const float rstd = 1.0f / sqrtf(wave_sum(ss) * (1.0f / 2048.0f) + RMS_EPS);
            if (lane == 0) rstdv[16 * p + r] = rstd;
            unsigned char* orow = (unsigned char*)(F.ws + WS_XN) + (size_t)tok * DM;
#pragma unroll
            for (int j = 0; j < 8; ++j) *(unsigned*)(orow + 4 * lane + 256 * j) = pk8(v[j].x * rstd * gg[j].x, v[j].y * rstd * gg[j].y, v[j].z * rstd * gg[j].z, v[j].w * rstd * gg[j].w); }
        __syncthreads();
        f32x4 acc[2] = {(f32x4){0.f, 0.f, 0.f, 0.f}, (f32x4){0.f, 0.f, 0.f, 0.f}};
#pragma unroll 4
        for (int blk = 0; blk < 16; ++blk) {
            const f32x4 a = *(const LAS f32x4*)(X + i * RT_PX + 256 * w + blk * 16 + 4 * kq); f32x4 b[2];
#pragma unroll
            for (int nt = 0; nt < 2; ++nt) b[nt] = *(const f32x4*)(gb + (size_t)nt * 16 * DM + blk * 16);
#pragma unroll
            for (int sI = 0; sI < 4; ++sI)
#pragma unroll
                for (int nt = 0; nt < 2; ++nt) acc[nt] = __builtin_amdgcn_mfma_f32_16x16x4f32(a[sI], b[nt][sI], acc[nt], 0, 0, 0);
        }
        __syncthreads();
#pragma unroll
        for (int nt = 0; nt < 2; ++nt)
#pragma unroll
            for (int rg = 0; rg < 4; ++rg) X[(w * 16 + kq * 4 + rg) * 33 + 16 * nt + i] = acc[nt][rg];
        __syncthreads();
        { const int tokr = F.tid >> 5, e = F.tid & 31; float sm = 0.f;
#pragma unroll
          for (int ww = 0; ww < 8; ++ww) sm += X[(ww * 16 + tokr) * 33 + e];
          logit[(16 * p + tokr) * 33 + e] = sm; }
        __syncthreads();
    }
    if (w == 0 && lane < 32) {
        const int tok = t0 + lane;
        float l[32]; const float rstd = rstdv[lane];
#pragma unroll
        for (int e = 0; e < 32; ++e) l[e] = logit[lane * 33 + e] * rstd + args.in[26][e];
        int sel[4]; float val[4];
#pragma unroll
        for (int k = 0; k < 4; ++k) { float best = -3.0e38f; int bi = 0;
#pragma unroll
            for (int e = 0; e < 32; ++e) { if (l[e] > best) { best = l[e]; bi = e; } }
            sel[k] = bi; val[k] = best;
#pragma unroll
            for (int e = 0; e < 32; ++e) l[e] = (e == bi) ? -3.0e38f : l[e]; }
        float gsum = 0.f; float gt[4];
#pragma unroll
        for (int k = 0; k < 4; ++k) { gt[k] = __expf(val[k] - val[0]); gsum += gt[k]; }
        int rank[4] = {0, 0, 0, 0}; unsigned mycnt = 0u;
#pragma unroll 4
        for (int e = 0; e < 32; ++e) { const bool has = (sel[0] == e) | (sel[1] == e) | (sel[2] == e) | (sel[3] == e);
            const unsigned long long mask = __ballot(has);
            const int rk = __popcll(mask & ((1ull << lane) - 1ull));
#pragma unroll
            for (int k = 0; k < 4; ++k) rank[k] = (sel[k] == e) ? rk : rank[k];
            mycnt = (lane == e) ? (unsigned)__popcll(mask) : mycnt; }
        const unsigned mybase = __hip_atomic_fetch_add((unsigned*)(F.ctl + CW_CNT + 64 * lane), mycnt, RLX_AGENT);
#pragma unroll
        for (int k = 0; k < 4; ++k) rank[k] += __shfl((int)mybase, sel[k]);
        int* RE = (int*)(F.ws + WS_RE); int* RR = (int*)(F.ws + WS_RR); float* RG = (float*)(F.ws + WS_RG);
#pragma unroll
        for (int k = 0; k < 4; ++k) { RE[tok * 4 + k] = sel[k]; RR[tok * 4 + k] = rank[k]; RG[tok * 4 + k] = gt[k] / gsum;
            ((int*)(F.ws + WS_INVT))[sel[k] * INVCAP + rank[k]] = tok; ((float*)(F.ws + WS_INVG))[sel[k] * INVCAP + rank[k]] = gt[k] / gsum; }
    }
}
__device__ __forceinline__ void moe_table(Frame& F) {
    __syncthreads();
    if (F.tid < 64) {
        const int lane = F.tid; const unsigned c = lane < 32 ? __hip_atomic_load((unsigned*)(F.ctl + CW_CNT + 64 * (lane & 31)), RLX_AGENT) : 0u;
        const unsigned tiles = (c + 255u) >> 8; const unsigned half = (tiles > 0u && c - (tiles - 1u) * 256u <= 128u) ? 1u : 0u; const unsigned full = tiles - half;
        unsigned incl = tiles, inf = full, inh = half;
#pragma unroll
        for (int off = 1; off < 32; off <<= 1) { const unsigned t = (unsigned)__shfl_up((int)incl, off), tf = (unsigned)__shfl_up((int)inf, off), th = (unsigned)__shfl_up((int)inh, off); if (lane >= off) { incl += t; inf += tf; inh += th; } }
        if (lane < 32) { F.MISC[64 + lane] = incl - tiles; F.MISC[128 + lane] = c; F.MISC[160 + lane] = inf - full; F.MISC[193 + lane] = inh - half;
            if (lane == 31) { F.MISC[64 + 32] = incl; F.MISC[160 + 32] = inf; F.MISC[193 + 32] = inh; } }
    }
    __syncthreads();
}
__device__ __forceinline__ void gather_row(Frame& F, int tok) {
    const int lane = F.lane;
    const int* RE = (const int*)(F.ws + WS_RE); const int* RR = (const int*)(F.ws + WS_RR); const float* RG = (const float*)(F.ws + WS_RG);
    const bf16* src = (const bf16*)(F.ws + WS_XN) + (size_t)tok * DM + lane * 8;
    v4u v[4];
#pragma unroll
    for (int j = 0; j < 4; ++j) v[j] = *(const v4u*)(src + 512 * j);
#pragma unroll
    for (int k = 0; k < 4; ++k) { const int e = RE[tok * 4 + k]; const int dest = (int)F.MISC[64 + e] * 256 + RR[tok * 4 + k];
        bf16* dst = (bf16*)(F.ws + WS_XS) + (size_t)dest * DM + lane * 8;
#pragma unroll
        for (int j = 0; j < 4; ++j) *(v4u*)(dst + 512 * j) = v[j];
        if (lane == 0) { ((int*)(F.ws + WS_POS))[tok * 4 + k] = dest; ((float*)(F.ws + WS_ROWGATE))[dest] = RG[tok * 4 + k]; } }
}
__device__ __forceinline__ void gather_row8(Frame& F, int tok) {
    const int lane = F.lane;
    const int* RE = (const int*)(F.ws + WS_RE); const int* RR = (const int*)(F.ws + WS_RR); const float* RG = (const float*)(F.ws + WS_RG);
    const unsigned char* src = (const unsigned char*)(F.ws + WS_XN) + (size_t)tok * DM + lane * 16;
    const v4u v0 = *(const v4u*)src, v1 = *(const v4u*)(src + 1024);
#pragma unroll
    for (int k = 0; k < 4; ++k) { const int e = RE[tok * 4 + k]; const int dest = (int)F.MISC[64 + e] * 256 + RR[tok * 4 + k];
        unsigned char* dst = (unsigned char*)(F.ws + WS_XS) + (size_t)dest * DM + lane * 16;
        *(v4u*)dst = v0; *(v4u*)(dst + 1024) = v1;
        if (lane == 0) { ((int*)(F.ws + WS_POS))[tok * 4 + k] = dest; ((float*)(F.ws + WS_ROWGATE))[dest] = RG[tok * 4 + k]; } }
}
__device__ __forceinline__ void final_rows(Frame& F, const Args& args, int gw, int NGW) {
    const int lane = F.lane; const int* RE = (const int*)(F.ws + WS_RE); const int* RR = (const int*)(F.ws + WS_RR);
    const float* g = args.in[33]; f32x4 gg[8];
#pragma unroll
    for (int j = 0; j < 4; ++j) { gg[2 * j] = *(const f32x4*)(g + 512 * j + lane * 8); gg[2 * j + 1] = *(const f32x4*)(g + 512 * j + lane * 8 + 4); }
    if (gw >= SEQ) return;
    v4u re = *(const v4u*)(RE + gw * 4), rr = *(const v4u*)(RR + gw * 4);
#pragma unroll 1
    for (int tok = gw; tok < SEQ; tok += NGW) {
        const float* xrow = (const float*)(F.ws + WS_X2) + (size_t)tok * DM;
        f32x4 xa[8]; v2u y[4][4];
#pragma unroll
        for (int j = 0; j < 4; ++j) { xa[2 * j] = *(const f32x4*)(xrow + 512 * j + lane * 8); xa[2 * j + 1] = *(const f32x4*)(xrow + 512 * j + lane * 8 + 4); }
#pragma unroll
        for (int k = 0; k < 4; ++k) { const int dest = (int)F.MISC[64 + re[k]] * 256 + (int)rr[k]; const unsigned char* yr = (const unsigned char*)(F.ws + WS_YS) + (size_t)dest * DM + lane * 8;
#pragma unroll
            for (int j = 0; j < 4; ++j) y[k][j] = *(const v2u*)(yr + 512 * j); }
        { const int tn = tok + NGW < SEQ ? tok + NGW : tok; re = *(const v4u*)(RE + tn * 4); rr = *(const v4u*)(RR + tn * 4); }
        float v[32];
#pragma unroll
        for (int j = 0; j < 4; ++j) { const f32x4 a = xa[2 * j], b = xa[2 * j + 1];
            v[j * 8 + 0] = a.x; v[j * 8 + 1] = a.y; v[j * 8 + 2] = a.z; v[j * 8 + 3] = a.w; v[j * 8 + 4] = b.x; v[j * 8 + 5] = b.y; v[j * 8 + 6] = b.z; v[j * 8 + 7] = b.w; }
#pragma unroll
        for (int k = 0; k < 4; ++k)
#pragma unroll
            for (int j = 0; j < 4; ++j) { const v2u yy = y[k][j];
                const f32x2 a0 = __builtin_amdgcn_cvt_pk_f32_fp8((int)yy.x, false), a1 = __builtin_amdgcn_cvt_pk_f32_fp8((int)yy.x, true), a2 = __builtin_amdgcn_cvt_pk_f32_fp8((int)yy.y, false), a3 = __builtin_amdgcn_cvt_pk_f32_fp8((int)yy.y, true);
                v[j * 8 + 0] += a0.x * 0.0625f; v[j * 8 + 1] += a0.y * 0.0625f; v[j * 8 + 2] += a1.x * 0.0625f; v[j * 8 + 3] += a1.y * 0.0625f; v[j * 8 + 4] += a2.x * 0.0625f; v[j * 8 + 5] += a2.y * 0.0625f; v[j * 8 + 6] += a3.x * 0.0625f; v[j * 8 + 7] += a3.y * 0.0625f; }
        float s = 0.f;
#pragma unroll
        for (int j = 0; j < 32; ++j) s += v[j] * v[j];
        const float rstd = 1.0f / sqrtf(wave_sum(s) * (1.0f / 2048.0f) + RMS_EPS);
        float* orow = F.out + (size_t)tok * DM;
#pragma unroll
        for (int j = 0; j < 4; ++j) { const f32x4 g0 = gg[2 * j], g1 = gg[2 * j + 1];
            *(f32x4*)(orow + 512 * j + lane * 8) = (f32x4){v[j * 8 + 0] * rstd * g0.x, v[j * 8 + 1] * rstd * g0.y, v[j * 8 + 2] * rstd * g0.z, v[j * 8 + 3] * rstd * g0.w};
            *(f32x4*)(orow + 512 * j + lane * 8 + 4) = (f32x4){v[j * 8 + 4] * rstd * g1.x, v[j * 8 + 5] * rstd * g1.y, v[j * 8 + 6] * rstd * g1.z, v[j * 8 + 7] * rstd * g1.w}; }
    }
}

__global__ void __launch_bounds__(NWAVES * 64, 2) fwd_kernel(Args args) {
    extern __shared__ __attribute__((aligned(16))) unsigned char lds[];
    Frame F;
    F.lds = (LAS unsigned char*)lds;
    F.MISC = (volatile LAS unsigned*)(F.lds + MISC_OFF);
    F.tid = threadIdx.x; F.lane = F.tid & 63; F.wave = __builtin_amdgcn_readfirstlane(F.tid >> 6);
    F.G = gridDim.x; { const int bx = blockIdx.x; F.vcu = (F.G % 8 == 0) ? (bx % 8) * (F.G / 8) + bx / 8 : bx; }
    F.ws = args.ws; F.ctl = (gu32*)(args.ws + WS_CTL); F.out = args.out;
    for (int u = F.tid; u < 256; u += NWAVES * 64) F.MISC[u] = 0u;
    __syncthreads();
    XcdBarrier bar; bar.bar = (unsigned*)(F.ctl + CW_BAR); bar.x = 0; bar.st = nullptr; bar.npart = F.G;
    if (N_LAUNCHES == 1) bar = xcd_barrier_post((unsigned*)(F.ctl + CW_BAR), F.MISC + 8, (unsigned)F.G);
    const bool split = (N_LAUNCHES == 1) && (F.G == 256); const bool s5wg = blockIdx.x < 128;
    XcdBarrier bar2 = bar; if (split && s5wg) bar2 = xcd_barrier_post((unsigned*)(F.ctl + CW_BAR2), F.MISC + 10, 128u);
#define SUB_BAR(k) do { if (split) { if (s5wg) xcd_barrier(bar2); } else if (BOTH(k)) GRID_BAR(); } while (0)
#define GRID_BAR() do { if (N_LAUNCHES == 1) xcd_barrier(bar); } while (0)
    const int lo = args.ph_lo, hi = args.ph_hi;
#ifndef PHASE_MASK
#define PHASE_MASK 0x1fff
#endif
#define IN(k) (((PHASE_MASK >> (k)) & 1) && lo <= (k) && (k) < hi)
#define BOTH(k) (IN(k) && IN((k) + 1))
#ifndef REP_MASK
#define REP_MASK 0
#endif
#define PH(k) if (IN(k))
    const int gw = F.vcu * NWAVES + F.wave, NGW = F.G * NWAVES;
    unsigned char* ws = args.ws;

    PH(0) { p0_prologue(F, args); if (!split && blockIdx.x < NG) s5_precompute(F, args, (int)blockIdx.x); if (BOTH(0)) GRID_BAR(); }
    PH(1) {
        constexpr int NGW1 = 104;
        if (!split || (int)blockIdx.x < NGW1) {
            pg8::Gemm g{DM, DM, DM}; DenseOrder S; S.init(ws + WS_XN, ws + WS_WTIN, SEQ, NPROJ, DM, DM, split ? NGW1 : F.G, (int)blockIdx.x);
            EpiInProj E{(bf16*)(ws + WS_ACAT), (bf16*)(ws + WS_Q)};
            pg8::gemm_phase<EpiInProj, DenseOrder, true, true>(F.lds + RING_OFF, g, S, E);
        } else if ((int)blockIdx.x - NGW1 < NG) s5_precompute(F, args, (int)blockIdx.x - NGW1);
        conv_queue(F, args);
        if (BOTH(1)) GRID_BAR();
    }
    PH(2) {
        if (!split || s5wg) { pg8::Gemm g{256, 512, 256}; GroupOrder S{(const char*)(ws + WS_ACAT), (const char*)(ws + WS_MS), (size_t)512 * 512 * 2, (size_t)256 * 256 * 2, (size_t)256 * 512 * 2, F.G, (int)blockIdx.x};
          EpiS5S E{(float*)(ws + WS_S5S)};
          pg8::gemm_phase<EpiS5S, GroupOrder, true, true>(F.lds + RING_OFF, g, S, E); }
        if (!split) { for (int u = F.vcu; u < 256; u += F.G) na_task(F, args, u >> 4, u & 15); }
        else if (!s5wg) { for (int u = (int)blockIdx.x - 128; u < 256; u += 128) na_task(F, args, u >> 4, u & 15); }
        SUB_BAR(2);
    }
    PH(3) { if (blockIdx.x < 128) s5_scan(F, args, (int)blockIdx.x >> 1, (int)blockIdx.x & 1); SUB_BAR(3); }
    PH(4) {
        pg8::Gemm g{512, 512, 512}; GroupOrder S{(const char*)(ws + WS_ACAT), (const char*)(ws + WS_MCAT), (size_t)512 * 512 * 2, (size_t)256 * 512 * 2, (size_t)256 * 512 * 2, F.G, (int)blockIdx.x};
        EpiS5Y E{(bf16*)(ws + WS_YG)};
        pg8::gemm_phase<EpiS5Y, GroupOrder, true, true>(F.lds + RING_OFF, g, S, E);
        SUB_BAR(4);
    }
    PH(5) {
        pg8::Gemm g{SW, SW, SW}; DenseOrder S; S.init(ws + WS_YG, ws + WS_WTGLU, SEQ, SW, SW, SW, F.G, (int)blockIdx.x);
        EpiGLU E{(const bf16*)(ws + WS_YG), args.in[19], (bf16*)(ws + WS_MIXED), (float*)(F.ctl + CW_SSQ)};
        pg8::gemm_phase<EpiGLU, DenseOrder, true, true>(F.lds + RING_OFF, g, S, E);
        if (BOTH(5)) GRID_BAR();
    }
    PH(7) {
        pg8::Gemm g{DM, DM, DM}; DenseOrder S; S.init(ws + WS_MIXED, ws + WS_WTOUT, SEQ, DM, DM, DM, F.G, (int)blockIdx.x);
        EpiOut E{args.in[0], (float*)(ws + WS_X2), (const float*)(F.ctl + CW_SSQ)};
        pg8::gemm_phase<EpiOut, DenseOrder, true, true>(F.lds + RING_OFF, g, S, E);
        if (BOTH(7)) GRID_BAR();
    }
    PH(8) {
        for (int tg = (int)blockIdx.x; tg < SEQ / 32; tg += F.G) router_group(F, args, tg);
        if (BOTH(8)) GRID_BAR();
    }
#if MOE_MODE == 2
#else
    PH(9) { moe_table(F); for (int m = gw; m < SEQ; m += NGW) gather_row(F, m); if (BOTH(9)) GRID_BAR(); }
#endif
    PH(10) {
        moe_table(F);
#if MOE_MODE == 2
        LAS int* ul = (LAS int*)(F.lds + RING_BYTES); moe_units(ul, F.MISC + 64, 16, F.G, F.vcu, F.tid);
        LAS unsigned* tokl = (LAS unsigned*)(F.lds + RING_BYTES + 256);
        { const int* INVT = (const int*)(ws + WS_INVT);
#pragma unroll
          for (int q = 0; q < 6; ++q) { const int idx = q * 512 + F.tid, i = idx >> 8, r = idx & 255; const int v = ul[4 * i], e = ul[4 * i + 1] & 255, rank = ul[4 * i + 3] + r;
              unsigned t = 0u; if ((v & 1) && rank < (int)F.MISC[128 + e]) t = (unsigned)INVT[e * INVCAP + rank];
              tokl[idx] = t; }
          __syncthreads(); }
        pg8::Gemm g{DM / 2, DM / 2, 64, 4096 * 128}; MoeOrder S{(const char*)(ws + WS_XN), (const char*)(ws + WS_WTGU), (size_t)256 * DM, (size_t)256 * 128, (size_t)4096 * DM, ul, tokl, (unsigned)DM};
        EpiGateUp8 E{args.in[28], args.in[30], (unsigned char*)(ws + WS_ACT)};
        pg8::gemm_phase<EpiGateUp8, MoeOrder, true, true, true, true, true>(F.lds + RING_OFF, g, S, E);
#elif MOE_MODE == 1
        pg8::Gemm g{DM, DM, DFF}; MoeOrderW S{(const char*)(ws + WS_XS), (size_t)256 * DM * 2, args.in[27], args.in[29], 0, 16, F.G, F.vcu, F.MISC + 64};
        EpiGateUpW E{args.in[28], args.in[30], (bf16*)(ws + WS_ACT)};
        pg8::gemm_phase_w32<EpiGateUpW, MoeOrderW>(F.lds + RING_OFF, g, S, E);
#else
        pg8::Gemm g{DM, DM, DM}; MoeOrder S{(const char*)(ws + WS_XS), (const char*)(ws + WS_WTGU), (size_t)256 * DM * 2, (size_t)256 * DM * 2, (size_t)4096 * DM * 2, 16, F.G, F.vcu, F.MISC + 64};
        EpiGateUp E{args.in[28], args.in[30], (bf16*)(ws + WS_ACT)};
        pg8::gemm_phase<EpiGateUp, MoeOrder, true, true>(F.lds + RING_OFF, g, S, E);
#endif
        if (BOTH(10)) GRID_BAR();
    }
    PH(11) {
        moe_table(F);
#if MOE_MODE == 2
        LAS int* ul = (LAS int*)(F.lds + RING_BYTES); moe_units(ul, F.MISC + 64, 8, F.G, F.vcu, F.tid);
        pg8::Gemm g{DFF / 2, DFF / 2, 64, DM * 128}; MoeOrder S{(const char*)(ws + WS_ACT), (const char*)(ws + WS_WTDN), (size_t)256 * DFF, (size_t)256 * 128, (size_t)DM * DFF, ul, nullptr, 0u};
        EpiDown8 E{args.in[32], (const float*)(ws + WS_INVG), (unsigned char*)(ws + WS_YS)};
        pg8::gemm_phase<EpiDown8, MoeOrder, true, true, true, true>(F.lds + RING_OFF, g, S, E);
#elif MOE_MODE == 1
        pg8::Gemm g{DFF, DFF, DM}; MoeOrderW S{(const char*)(ws + WS_ACT), (size_t)256 * DFF * 2, args.in[31], args.in[31], 1, 8, F.G, F.vcu, F.MISC + 64};
        EpiDownW E{args.in[32], (const float*)(ws + WS_ROWGATE), (bf16*)(ws + WS_YS)};
        pg8::gemm_phase_w32<EpiDownW, MoeOrderW>(F.lds + RING_OFF, g, S, E);
#else
        pg8::Gemm g{DFF, DFF, DFF}; MoeOrder S{(const char*)(ws + WS_ACT), (const char*)(ws + WS_WTDN), (size_t)256 * DFF * 2, (size_t)256 * DFF * 2, (size_t)DM * DFF * 2, 8, F.G, F.vcu, F.MISC + 64};
        EpiDown E{args.in[32], (const float*)(ws + WS_ROWGATE), (bf16*)(ws + WS_YS)};
        pg8::gemm_phase<EpiDown, MoeOrder, true, true>(F.lds + RING_OFF, g, S, E);
#endif
        if (BOTH(11)) GRID_BAR();
    }
    PH(12) { moe_table(F); final_rows(F, args, gw, NGW); }
#undef IN
#undef BOTH
}

extern "C" void kernel_launch(void* const* d_in, const int* in_sizes, int n_in, void* d_out, int out_size, void* d_ws, size_t ws_size, hipStream_t stream) {
    static int grid = 0;
    if (grid == 0) {
        if (n_in != 34 || out_size != SEQ * DM || ws_size < WS_END) { fprintf(stderr, "kernel_launch: unexpected shapes (n_in %d out %d ws %zu)\n", n_in, out_size, ws_size); grid = -1; return; }
        int dev = 0, cus = 0, per_cu = 0;
        if (hipGetDevice(&dev) != hipSuccess || hipDeviceGetAttribute(&cus, hipDeviceAttributeMultiprocessorCount, dev) != hipSuccess) { grid = -1; return; }
        if (hipFuncSetAttribute((const void*)fwd_kernel, hipFuncAttributeMaxDynamicSharedMemorySize, LDS_BYTES) != hipSuccess) { fprintf(stderr, "kernel_launch: hipFuncSetAttribute failed\n"); grid = -1; return; }
        if (hipOccupancyMaxActiveBlocksPerMultiprocessor(&per_cu, (const void*)fwd_kernel, NWAVES * 64, LDS_BYTES) != hipSuccess || per_cu < 1) fprintf(stderr, "kernel_launch: occupancy query reports %d\n", per_cu);
        (void)hipGetLastError();
        grid = cus;
    }
    if (grid < 0) return;
    (void)hipMemsetAsync((char*)d_ws + WS_CTL, 0, CTL_ZERO_BYTES, stream);
    Args a{};
    for (int i = 0; i < 34; ++i) a.in[i] = (const float*)d_in[i];
    a.out = (float*)d_out; a.ws = (unsigned char*)d_ws;
    if (N_LAUNCHES == 1) { a.ph_lo = 0; a.ph_hi = NPHASE; hipLaunchKernelGGL(fwd_kernel, dim3(grid), dim3(NWAVES * 64), LDS_BYTES, stream, a); }
    else for (int li = 0; li < NPHASE; ++li) { a.ph_lo = li; a.ph_hi = li + 1;
        for (int rep = 0; rep < 1 + ((REP_MASK >> li) & 1); ++rep) {
            if (rep > 0 && li == 8) (void)hipMemsetAsync((char*)d_ws + WS_CTL, 0, CTL_ZERO_BYTES, stream);
            hipLaunchKernelGGL(fwd_kernel, dim3(grid), dim3(NWAVES * 64), LDS_BYTES, stream, a); } }
}
```

```cpp
#include <hip/hip_runtime.h>
#include <cstdio>
#include <cstdint>
namespace pg8 {
#define PG8_LAS __attribute__((address_space(3)))
typedef unsigned short bf16_t;
typedef short bf16x8 __attribute__((ext_vector_type(8)));
typedef float f32x4 __attribute__((ext_vector_type(4)));
typedef unsigned u32x4 __attribute__((ext_vector_type(4)));
typedef float f32x2 __attribute__((ext_vector_type(2)));
typedef int i32x4 __attribute__((ext_vector_type(4)));
typedef int i32x8 __attribute__((ext_vector_type(8)));
constexpr int BM = 256, BK = 64, HALF = 128, HTB = HALF * BK * 2  , STAGE_BYTES = 8 * HTB;

__host__ __device__ __forceinline__ int lds_byte(int r, int c) { const int st = (r >> 4) * 2 + (c >> 5), rr = r & 15, cc = c & 31, ob = rr * 64 + cc * 2; return st * 1024 + (ob ^ (((ob >> 9) & 1) << 5)); }
__host__ __device__ __forceinline__ void stage_rc(int b, int& R, int& C) { const int st = b / 1024, sb = b % 1024, swz = sb ^ (((sb >> 9) & 1) << 5); R = (st >> 1) * 16 + swz / 64; C = (st & 1) * 32 + (swz % 64) / 2; }
__host__ __device__ __forceinline__ int perm32(int rho) { const int n = rho >> 4, i = rho & 15; return 8 * (i >> 2) + 4 * n + (i & 3); }

struct Unit { int pm, pn, aux, half, r0; const char* a; const char* b; };
struct Gemm { int K, lda, ldb; int kstepB = 0; };

__device__ __forceinline__ unsigned cvt_pk_bf16(float lo, float hi) { unsigned r; asm volatile("v_cvt_pk_bf16_f32 %0, %1, %2" : "=v"(r) : "v"(lo), "v"(hi)); return r; }

template <class Epi, class Sched, bool ALIGN_EPI = false, bool SP2 = false, bool FP8 = false, bool HALFU = false, bool GATHER = false>
__device__ __forceinline__ void gemm_phase(PG8_LAS unsigned char* lds, const Gemm g, const Sched& S, const Epi& E) {
    const int tid = threadIdx.x, wid = __builtin_amdgcn_readfirstlane(tid >> 6), lane = tid & 63, wr = wid >> 2, wc = wid & 3, fr = lane & 15, fq = lane >> 4;
    int Kop = g.K; asm volatile("" : "+s"(Kop));
    const int K = Kop, nt = K / BK;
    unsigned voffA[2], voffB[2];
#pragma unroll
    for (int i = 0; i < 2; ++i) { int R, C; stage_rc(tid * 16 + i * 8192, R, C); const int Rb = Epi::PERM ? ((R & ~31) + perm32(R & 31)) : R;
        voffA[i] = (unsigned)(R * g.lda + C) * 2u; voffB[i] = (unsigned)(Rb * g.ldb + C) * 2u; }
    const size_t kstep = (size_t)(BK * 2);
    const size_t kstepB = g.kstepB ? (size_t)g.kstepB : kstep;
    const size_t hstepA = (size_t)HALF * g.lda * 2, hstepB = (size_t)HALF * g.ldb * 2;
    const unsigned ldsw = (unsigned)wid * 1024u;
    const int aoff = lds_byte(wr * 64 + fr, fq * 8), boff = lds_byte(wc * 32 + fr, fq * 8);
#define PG8_SA(b, h) (((b) * 2 + (h)) * HTB)
#define PG8_SB(b, h) ((4 + (b) * 2 + (h)) * HTB)
#define PG8_STAGE(bufoff, gbase, voff) do { _Pragma("unroll") for (int _i = 0; _i < 2; ++_i) \
        __builtin_amdgcn_global_load_lds((const unsigned*)((const char*)(gbase) + (voff)[_i]), (PG8_LAS unsigned*)(lds + (bufoff) + ldsw + _i * 8192), 16, 0, 0); } while (0)
#define PG8_RD(off) (*(const PG8_LAS i32x4*)(lds + (off)))
#define PG8_STAGEG(bufoff, kb, GG) do { _Pragma("unroll") for (int _i = 0; _i < 2; ++_i) \
        __builtin_amdgcn_global_load_lds((const unsigned*)(S.A + (kb) + (GG)[_i]), (PG8_LAS unsigned*)(lds + (bufoff) + ldsw + _i * 8192), 16, 0, 0); } while (0)
#define PG8_FILLG(GG, idx) do { _Pragma("unroll") for (int _h = 0; _h < 2; ++_h) _Pragma("unroll") for (int _i = 0; _i < 2; ++_i) \
        GG[_h][_i] = (S.tokl[(idx) * 256 + _h * 128 + _i * 64 + gR0] & 8191u) * S.rowb + gC0; } while (0)
#define PG8_LDA(dst, b, h) do { if constexpr (FP8) { _Pragma("unroll") for (int m = 0; m < 4; ++m) dst##8[m] = __builtin_shufflevector(PG8_RD(PG8_SA(b, h) + aoff + m * 2048), PG8_RD(PG8_SA(b, h) + aoff + m * 2048 + 1024), 0, 1, 2, 3, 4, 5, 6, 7); } \
        else { _Pragma("unroll") for (int m = 0; m < 4; ++m) _Pragma("unroll") for (int k = 0; k < 2; ++k) dst[m][k] = *(const PG8_LAS bf16x8*)(lds + PG8_SA(b, h) + aoff + m * 2048 + k * 1024); } } while (0)
#define PG8_LDB(dst, b, h) do { if constexpr (FP8) { _Pragma("unroll") for (int n = 0; n < 2; ++n) dst##8[n] = __builtin_shufflevector(PG8_RD(PG8_SB(b, h) + boff + n * 2048), PG8_RD(PG8_SB(b, h) + boff + n * 2048 + 1024), 0, 1, 2, 3, 4, 5, 6, 7); } \
        else { _Pragma("unroll") for (int n = 0; n < 2; ++n) _Pragma("unroll") for (int k = 0; k < 2; ++k) dst[n][k] = *(const PG8_LAS bf16x8*)(lds + PG8_SB(b, h) + boff + n * 2048 + k * 1024); } } while (0)
#define PG8_MMA(ai, bj, At, Bt) do { __builtin_amdgcn_s_setprio(1); \
        if constexpr (FP8) { _Pragma("unroll") for (int m = 0; m < 4; ++m) _Pragma("unroll") for (int n = 0; n < 2; ++n) \
            asm volatile("v_mfma_scale_f32_16x16x128_f8f6f4 %0, %1, %2, %0, %3, %3 op_sel_hi:[0,0,0]" : "+v"(acc[ai][bj][m][n]) : "v"(Bt##8[n]), "v"(At##8[m]), "v"(scl)); } \
        else { _Pragma("unroll") for (int m = 0; m < 4; ++m) _Pragma("unroll") for (int n = 0; n < 2; ++n) _Pragma("unroll") for (int k = 0; k < 2; ++k) \
            acc[ai][bj][m][n] = __builtin_amdgcn_mfma_f32_16x16x32_bf16(Bt[n][k], At[m][k], acc[ai][bj][m][n], 0, 0, 0); } \
        __builtin_amdgcn_s_setprio(0); } while (0)
#define PG8_WAIT_V(n) asm volatile("s_waitcnt vmcnt(" #n ")" ::: "memory")
#define PG8_WAIT_L(n) asm volatile("s_waitcnt lgkmcnt(" #n ")" ::: "memory")
#define PG8_BAR __builtin_amdgcn_s_barrier()
#define PG8_SCHED __builtin_amdgcn_sched_barrier(0)
    Unit cur, nxt; int ui = 0;
    if (!S.next(0, cur)) return;
    int gR0 = 0; unsigned gC0 = 0u; unsigned gC[2][2], gN[2][2];
    if constexpr (GATHER) { int R, C; stage_rc(tid * 16, R, C); gR0 = R; gC0 = (unsigned)C * 2u; PG8_FILLG(gC, 0); }
    f32x4 acc[2][2][4][2];
#pragma unroll
    for (int a = 0; a < 2; ++a)
#pragma unroll
        for (int b = 0; b < 2; ++b)
#pragma unroll
            for (int m = 0; m < 4; ++m)
#pragma unroll
                for (int n = 0; n < 2; ++n) acc[a][b][m][n] = (f32x4){0.f, 0.f, 0.f, 0.f};
    bf16x8 At[4][2], B0[2][2], B1[2][2]; i32x8 At8[4], B08[2], B18[2];
    const int scl = 0x7f7f7f7f;
    const char* cA = cur.a; const char* cB = cur.b; bool hu = HALFU && cur.half != 0;
    S.a_ready(cur);
    if constexpr (Epi::LDSB) E.stage(cur, 0, wid, lane);
    if constexpr (SP2) {
        PG8_STAGE(PG8_SB(0, 0), cB, voffB); PG8_STAGE(PG8_SB(0, 1), cB + hstepB, voffB);
        if constexpr (GATHER) { PG8_STAGEG(PG8_SA(0, 0), 0, gC[0]); PG8_STAGEG(PG8_SA(0, 1), 0, gC[1]); } else { PG8_STAGE(PG8_SA(0, 0), cA, voffA); PG8_STAGE(PG8_SA(0, 1), cA + hstepA, voffA); }
        if (wr == 1) PG8_BAR;
        PG8_WAIT_V(2); PG8_BAR;
        PG8_STAGE(PG8_SB(1, 0), cB + kstepB, voffB); if constexpr (GATHER) PG8_STAGEG(PG8_SA(1, 0), kstep, gC[0]); else PG8_STAGE(PG8_SA(1, 0), cA + kstep, voffA); PG8_STAGE(PG8_SB(1, 1), cB + hstepB + kstepB, voffB);
        PG8_WAIT_V(6); PG8_BAR;
    } else {
        PG8_STAGE(PG8_SB(0, 0), cB, voffB); PG8_STAGE(PG8_SA(0, 0), cA, voffA); PG8_STAGE(PG8_SB(0, 1), cB + hstepB, voffB); PG8_STAGE(PG8_SA(0, 1), cA + hstepA, voffA);
        if (wr == 1) PG8_BAR;
        PG8_WAIT_V(4); PG8_BAR;
        PG8_STAGE(PG8_SB(1, 0), cB + kstepB, voffB); PG8_STAGE(PG8_SA(1, 0), cA + kstep, voffA); PG8_STAGE(PG8_SB(1, 1), cB + hstepB + kstepB, voffB);
        PG8_WAIT_V(6); PG8_BAR;
    }
    for (;;) {
        const bool has_next = S.next(ui + 1, nxt);
        const char* nA = has_next ? nxt.a : cA; const char* nB = has_next ? nxt.b : cB;
        if constexpr (GATHER) { if (has_next) PG8_FILLG(gN, ui + 1); else { gN[0][0] = gC[0][0]; gN[0][1] = gC[0][1]; gN[1][0] = gC[1][0]; gN[1][1] = gC[1][1]; } }
        for (int t = 0; t < nt; t += 2) {
            const bool last = (t == nt - 2);
            const char* a1 = cA + (size_t)(t + 1) * kstep;
            const char* a2 = last ? nA : cA + (size_t)(t + 2) * kstep; const char* b2 = last ? nB : cB + (size_t)(t + 2) * kstepB;
            const char* a3 = a2 + kstep; const char* b3 = b2 + kstepB;
            if (last && has_next) S.a_ready(nxt);
            if constexpr (Epi::MIDSCALE) { if (t == nt / 2) E.mid(acc, cur, wr, wc, fr, fq); }
            unsigned gs[2][2]; size_t k2 = 0;
            if constexpr (GATHER) { k2 = last ? 0 : (size_t)(t + 2) * kstep; gs[0][0] = last ? gN[0][0] : gC[0][0]; gs[0][1] = last ? gN[0][1] : gC[0][1]; gs[1][0] = last ? gN[1][0] : gC[1][0]; gs[1][1] = last ? gN[1][1] : gC[1][1]; }
            if constexpr (SP2) {
            PG8_LDB(B0, 0, 0); PG8_LDB(B1, 0, 1); PG8_SCHED; PG8_LDA(At, 0, 0); if constexpr (GATHER) PG8_STAGEG(PG8_SA(1, 1), (size_t)(t + 1) * kstep, gC[1]); else PG8_STAGE(PG8_SA(1, 1), a1 + hstepA, voffA);
            if ((int)Epi::NST != 0 && t == 0 && ui > 0) { if constexpr ((int)Epi::NST == 8) PG8_WAIT_V(16); else PG8_WAIT_V(12); } else PG8_WAIT_V(8);
            PG8_WAIT_L(0); PG8_BAR; PG8_MMA(0, 0, At, B0); PG8_MMA(0, 1, At, B1); PG8_BAR; PG8_SCHED;
            if (!(HALFU && hu)) PG8_LDA(At, 0, 1); PG8_STAGE(PG8_SB(0, 0), b2, voffB); PG8_STAGE(PG8_SB(0, 1), b2 + hstepB, voffB); if constexpr (GATHER) PG8_STAGEG(PG8_SA(0, 0), k2, gs[0]); else PG8_STAGE(PG8_SA(0, 0), a2, voffA);
            PG8_WAIT_V(8); PG8_WAIT_L(0); PG8_BAR; if (!(HALFU && hu)) { PG8_MMA(1, 0, At, B0); PG8_MMA(1, 1, At, B1); } PG8_BAR; PG8_SCHED;
            PG8_LDB(B0, 1, 0); PG8_LDB(B1, 1, 1); PG8_SCHED; PG8_LDA(At, 1, 0); if constexpr (GATHER) PG8_STAGEG(PG8_SA(0, 1), k2, gs[1]); else PG8_STAGE(PG8_SA(0, 1), a2 + hstepA, voffA);
            PG8_WAIT_V(8); PG8_WAIT_L(0); PG8_BAR; PG8_MMA(0, 0, At, B0); PG8_MMA(0, 1, At, B1); PG8_BAR; PG8_SCHED;
            if (!(HALFU && hu)) PG8_LDA(At, 1, 1); PG8_STAGE(PG8_SB(1, 0), b3, voffB); PG8_STAGE(PG8_SB(1, 1), b3 + hstepB, voffB); if constexpr (GATHER) PG8_STAGEG(PG8_SA(1, 0), k2 + kstep, gs[0]); else PG8_STAGE(PG8_SA(1, 0), a3, voffA);
            PG8_WAIT_V(8); PG8_WAIT_L(0); PG8_BAR; if (!(HALFU && hu)) { PG8_MMA(1, 0, At, B0); PG8_MMA(1, 1, At, B1); } PG8_BAR; PG8_SCHED;
            } else {
            PG8_LDB(B0, 0, 0); PG8_SCHED; PG8_LDA(At, 0, 0); PG8_STAGE(PG8_SA(1, 1), a1 + hstepA, voffA);
            PG8_WAIT_L(8); PG8_BAR; PG8_WAIT_L(0); PG8_MMA(0, 0, At, B0); PG8_BAR; PG8_SCHED;
            PG8_LDB(B1, 0, 1); PG8_STAGE(PG8_SB(0, 0), b2, voffB);
            PG8_BAR; PG8_WAIT_L(0); PG8_MMA(0, 1, At, B1); PG8_BAR;
            PG8_LDA(At, 0, 1); PG8_STAGE(PG8_SA(0, 0), a2, voffA);
            PG8_BAR; PG8_WAIT_L(0); PG8_MMA(1, 0, At, B0); PG8_BAR; PG8_SCHED;
            PG8_STAGE(PG8_SB(0, 1), b2 + hstepB, voffB);
            PG8_WAIT_V(6); PG8_BAR; PG8_MMA(1, 1, At, B1); PG8_BAR;
            PG8_LDB(B0, 1, 0); PG8_SCHED; PG8_LDA(At, 1, 0); PG8_STAGE(PG8_SA(0, 1), a2 + hstepA, voffA);
            PG8_WAIT_L(8); PG8_BAR; PG8_WAIT_L(0); PG8_MMA(0, 0, At, B0); PG8_BAR; PG8_SCHED;
            PG8_LDB(B1, 1, 1); PG8_STAGE(PG8_SB(1, 0), b3, voffB);
            PG8_BAR; PG8_WAIT_L(0); PG8_MMA(0, 1, At, B1); PG8_BAR;
            PG8_LDA(At, 1, 1); PG8_STAGE(PG8_SA(1, 0), a3, voffA);
            PG8_BAR; PG8_WAIT_L(0); PG8_MMA(1, 0, At, B0); PG8_BAR; PG8_SCHED;
            PG8_STAGE(PG8_SB(1, 1), b3 + hstepB, voffB);
            PG8_WAIT_V(6); PG8_BAR; PG8_MMA(1, 1, At, B1); PG8_BAR;
            }
        }
        if constexpr (FP8) asm volatile("s_nop 15\n\ts_nop 15" ::: "memory");
        if constexpr (ALIGN_EPI) { if (wr == 0) PG8_BAR; }
        if constexpr (!Epi::AFTER_DRAIN) { if constexpr (Epi::LDSB) E(acc, cur, wr, wc, fr, fq, ui); else E(acc, cur, wr, wc, fr, fq); S.done(cur); }
        if (!has_next) break;
#pragma unroll
        for (int a = 0; a < 2; ++a)
#pragma unroll
            for (int b = 0; b < 2; ++b)
#pragma unroll
                for (int m = 0; m < 4; ++m)
#pragma unroll
                    for (int n = 0; n < 2; ++n) acc[a][b][m][n] = (f32x4){0.f, 0.f, 0.f, 0.f};
        cur = nxt; cA = nA; cB = nB; ++ui; hu = HALFU && cur.half != 0;
        if constexpr (Epi::LDSB) E.stage(cur, ui, wid, lane);
        if constexpr (GATHER) { gC[0][0] = gN[0][0]; gC[0][1] = gN[0][1]; gC[1][0] = gN[1][0]; gC[1][1] = gN[1][1]; }
        if constexpr (ALIGN_EPI) { if (wr == 1) PG8_BAR; }
    }
    PG8_WAIT_V(0);
    if constexpr (!ALIGN_EPI) { if (wr == 0) PG8_BAR; }
    PG8_BAR;
    if constexpr (Epi::AFTER_DRAIN) { E.fused(acc, cur, wr, wc, fr, fq, lds, wid, lane); S.done(cur); }
#undef PG8_SA
#undef PG8_SB
#undef PG8_STAGE
#undef PG8_RD
#undef PG8_STAGEG
#undef PG8_FILLG
#undef PG8_LDA
#undef PG8_LDB
#undef PG8_MMA
#undef PG8_WAIT_V
#undef PG8_WAIT_L
#undef PG8_BAR
#undef PG8_SCHED
}

template <class Epi, class Sched>
__device__ __forceinline__ void gemm_phase_w32(PG8_LAS unsigned char* lds, const Gemm g, const Sched& S, const Epi& E) {
    const int tid = threadIdx.x, wid = __builtin_amdgcn_readfirstlane(tid >> 6), lane = tid & 63, wr = wid >> 2, wc = wid & 3, fr = lane & 15, fq = lane >> 4;
    int Kop = g.K; asm volatile("" : "+s"(Kop));
    const int K = Kop, nt = K / BK;
    unsigned voffA; { int R, C; stage_rc(tid * 16, R, C); voffA = (unsigned)(R * g.lda + C) * 2u; }
    const unsigned kstep = (unsigned)(BK * 2), hstepA = (unsigned)HALF * g.lda * 2u, qstepA = 64u * g.lda * 2u;
    const __amdgpu_buffer_rsrc_t rsA = S.rsrcA();
    const unsigned rowB = (unsigned)g.ldb * 4u, kstepB = (unsigned)BK * g.ldb * 4u;
    const __amdgpu_buffer_rsrc_t rsrc = S.rsrc(wid);
    const unsigned ldsw = (unsigned)wid * 1024u;
    const int aoff = lds_byte(wr * 64 + fr, fq * 8), boff = lds_byte(wc * 32 + fr, fq * 8);
    const int wq = (lane & 3) + 4 * (lane >> 5), kc = (lane >> 2) & 7, hh = wq & 1, wfq = wq >> 1;
    const unsigned voffW = (unsigned)((8 * kc) * g.ldb + 4 * wq) * 4u;
    const unsigned ldsW0 = (unsigned)(wr * HTB + lds_byte(wc * 32 + 16 * hh + 4 * wfq, 8 * kc)), h64 = (unsigned)hh * 64u;
#define PG8_SA(b, h) (((b) * 2 + (h)) * HTB)
#define PG8_SB(b, h) ((4 + (b) * 2 + (h)) * HTB)
#define PG8_STAGE(bufoff, goff, voff) do { _Pragma("unroll") for (int _i = 0; _i < 2; ++_i) \
        __builtin_amdgcn_raw_ptr_buffer_load_lds(rsA, (PG8_LAS void*)(lds + (bufoff) + ldsw + _i * 8192), 16, (voff), (goff) + _i * qstepA, 0, 0); } while (0)
#define PG8_LDA(dst, b, h) do { _Pragma("unroll") for (int m = 0; m < 4; ++m) _Pragma("unroll") for (int k = 0; k < 2; ++k) dst[m][k] = *(const PG8_LAS bf16x8*)(lds + PG8_SA(b, h) + aoff + m * 2048 + k * 1024); } while (0)
#define PG8_LDB(dst, b, h) do { _Pragma("unroll") for (int n = 0; n < 2; ++n) _Pragma("unroll") for (int k = 0; k < 2; ++k) dst[n][k] = *(const PG8_LAS bf16x8*)(lds + PG8_SB(b, h) + boff + n * 2048 + k * 1024); } while (0)
#define PG8_MMA(ai, bj, At, Bt) do { __builtin_amdgcn_s_setprio(1); _Pragma("unroll") for (int m = 0; m < 4; ++m) _Pragma("unroll") for (int n = 0; n < 2; ++n) _Pragma("unroll") for (int k = 0; k < 2; ++k) \
        acc[ai][bj][m][n] = __builtin_amdgcn_mfma_f32_16x16x32_bf16(Bt[n][k], At[m][k], acc[ai][bj][m][n], 0, 0, 0); __builtin_amdgcn_s_setprio(0); } while (0)
#define PG8_LOADB(wo) do { const unsigned o_ = (wo); _Pragma("unroll") for (int i_ = 0; i_ < 8; ++i_) rb[i_] = __builtin_bit_cast(f32x4, __builtin_amdgcn_raw_buffer_load_b128(rsrc, voffW, o_ + (unsigned)i_ * rowB, 0)); } while (0)
#define PG8_WRITEB(b) do { _Pragma("unroll") for (int j_ = 0; j_ < 4; ++j_) { u32x4 o_; o_.x = cvt_pk_bf16(rb[0][j_], rb[1][j_]); o_.y = cvt_pk_bf16(rb[2][j_], rb[3][j_]); o_.z = cvt_pk_bf16(rb[4][j_], rb[5][j_]); o_.w = cvt_pk_bf16(rb[6][j_], rb[7][j_]); \
        *(PG8_LAS u32x4*)(lds + PG8_SB(b, 0) + ldsW0 + ((h64 + 64u * j_) & 192u)) = o_; } } while (0)
#define PG8_WAIT_V(n) asm volatile("s_waitcnt vmcnt(" #n ")" ::: "memory")
#define PG8_WAIT_L(n) asm volatile("s_waitcnt lgkmcnt(" #n ")" ::: "memory")
#define PG8_BAR __builtin_amdgcn_s_barrier()
#define PG8_SCHED __builtin_amdgcn_sched_barrier(0)
    Unit cur, nxt; int ui = 0;
    if (!S.next(0, cur)) return;
    f32x4 acc[2][2][4][2];
#pragma unroll
    for (int a = 0; a < 2; ++a)
#pragma unroll
        for (int b = 0; b < 2; ++b)
#pragma unroll
            for (int m = 0; m < 4; ++m)
#pragma unroll
                for (int n = 0; n < 2; ++n) acc[a][b][m][n] = (f32x4){0.f, 0.f, 0.f, 0.f};
    bf16x8 At[4][2], B0[2][2], B1[2][2];
    f32x4 rb[8];
    unsigned cA = S.aoff(cur); unsigned cW = S.woff(cur, wid);
    PG8_LOADB(cW); PG8_STAGE(PG8_SA(0, 0), cA, voffA); PG8_STAGE(PG8_SA(0, 1), cA + hstepA, voffA);
    PG8_WRITEB(0);
    PG8_LOADB(cW + kstepB); PG8_STAGE(PG8_SA(1, 0), cA + kstep, voffA);
    PG8_WAIT_V(10); PG8_WAIT_L(0); PG8_BAR;
    if (wr == 1) PG8_BAR;
    for (;;) {
        const bool has_next = S.next(ui + 1, nxt);
        const unsigned nA = has_next ? S.aoff(nxt) : cA; const unsigned nW = has_next ? S.woff(nxt, wid) : cW;
        for (int t = 0; t < nt; t += 2) {
            const bool last = (t == nt - 2);
            const unsigned a1 = cA + (unsigned)(t + 1) * kstep;
            const unsigned a2 = last ? nA : cA + (unsigned)(t + 2) * kstep; const unsigned w2 = last ? nW : cW + (unsigned)(t + 2) * kstepB;
            const unsigned a3 = a2 + kstep; const unsigned w3 = w2 + kstepB;
            PG8_LDB(B0, 0, 0); PG8_LDB(B1, 0, 1); PG8_SCHED; PG8_LDA(At, 0, 0); PG8_STAGE(PG8_SA(1, 1), a1 + hstepA, voffA);
            PG8_WAIT_V(12); PG8_WAIT_L(0); PG8_BAR; PG8_MMA(0, 0, At, B0); PG8_MMA(0, 1, At, B1); PG8_BAR; PG8_SCHED;
            PG8_LDA(At, 0, 1); PG8_WRITEB(1); PG8_LOADB(w2); PG8_STAGE(PG8_SA(0, 0), a2, voffA);
            PG8_WAIT_V(12); PG8_WAIT_L(0); PG8_BAR; PG8_MMA(1, 0, At, B0); PG8_MMA(1, 1, At, B1); PG8_BAR; PG8_SCHED;
            PG8_LDB(B0, 1, 0); PG8_LDB(B1, 1, 1); PG8_SCHED; PG8_LDA(At, 1, 0); PG8_STAGE(PG8_SA(0, 1), a2 + hstepA, voffA);
            PG8_WAIT_V(12); PG8_WAIT_L(0); PG8_BAR; PG8_MMA(0, 0, At, B0); PG8_MMA(0, 1, At, B1); PG8_BAR; PG8_SCHED;
            PG8_LDA(At, 1, 1); PG8_WRITEB(0); PG8_LOADB(w3); PG8_STAGE(PG8_SA(1, 0), a3, voffA);
            PG8_WAIT_V(12); PG8_WAIT_L(0); PG8_BAR; PG8_MMA(1, 0, At, B0); PG8_MMA(1, 1, At, B1); PG8_BAR; PG8_SCHED;
        }
        if (wr == 0) PG8_BAR;
        E(acc, cur, wr, wc, fr, fq);
        if (!has_next) break;
#pragma unroll
        for (int a = 0; a < 2; ++a)
#pragma unroll
            for (int b = 0; b < 2; ++b)
#pragma unroll
                for (int m = 0; m < 4; ++m)
#pragma unroll
                    for (int n = 0; n < 2; ++n) acc[a][b][m][n] = (f32x4){0.f, 0.f, 0.f, 0.f};
        cur = nxt; cA = nA; cW = nW; ++ui;
        if (wr == 1) PG8_BAR;
    }
    PG8_WAIT_V(0);
    asm volatile("" :: "v"(rb[0]), "v"(rb[1]), "v"(rb[2]), "v"(rb[3]), "v"(rb[4]), "v"(rb[5]), "v"(rb[6]), "v"(rb[7]));
    PG8_BAR;
#undef PG8_SA
#undef PG8_SB
#undef PG8_STAGE
#undef PG8_LDA
#undef PG8_LDB
#undef PG8_MMA
#undef PG8_LOADB
#undef PG8_WRITEB
#undef PG8_WAIT_V
#undef PG8_WAIT_L
#undef PG8_BAR
#undef PG8_SCHED
}
}

constexpr int NWAVES = 8;
constexpr int SEQ = 8192, DM = 2048, NPROJ = 4096, SW = 1024, NG = 64, NE = 32, DFF = 2048;
constexpr int MPAD = 40960;
constexpr float RMS_EPS = 1e-5f;
constexpr int NPHASE = 13;
#ifndef MOE_MODE
#define MOE_MODE 2
#endif
#ifndef MK_N_LAUNCHES
#define MK_N_LAUNCHES 1
#endif
constexpr int N_LAUNCHES = MK_N_LAUNCHES;

constexpr size_t MiB = 1u << 20;
constexpr size_t WS_CTL = 0, CTL_ZERO_BYTES = 1 * MiB;
constexpr size_t WS_GW = 1 * MiB;
constexpr size_t WS_RE = 2 * MiB, WS_RR = WS_RE + 128 * 1024, WS_RG = WS_RE + 256 * 1024, WS_POS = WS_RE + 384 * 1024, WS_ROWGATE = WS_RE + 512 * 1024;
constexpr size_t WS_WTIN = 4 * MiB, WS_WTGLU = 20 * MiB, WS_WTOUT = 22 * MiB, WS_MS = 30 * MiB, WS_MCAT = 38 * MiB;
constexpr size_t WS_XN = 54 * MiB, WS_Q = 86 * MiB, WS_K = 102 * MiB, WS_V = 118 * MiB, WS_S5S = 134 * MiB, WS_ACAT = 166 * MiB;
constexpr size_t WS_YG = 198 * MiB, WS_YSSM = 214 * MiB, WS_YNA = 230 * MiB, WS_MIXED = 246 * MiB, WS_X2 = 278 * MiB;
constexpr size_t WS_XS = 342 * MiB, WS_ACT = 502 * MiB, WS_YS = 662 * MiB, WS_WTGU = 822 * MiB, WS_WTDN = 1334 * MiB, WS_END = 1590 * MiB;
constexpr int INVCAP = 8448;
constexpr size_t WS_INVT = WS_XS, WS_INVG = WS_XS + 2 * MiB;
constexpr int CW_SSQ = 32768;
constexpr int CW_BAR2 = 20480;
constexpr int CW_TMO = 0, CW_BAR = 4096, CW_CNT = 8192, CW_Q = 12288;

constexpr int RING_OFF = 0, RING_BYTES = 131072;
constexpr int LDS_BYTES = 147456;
constexpr int MISC_OFF = LDS_BYTES - 1024;

#define GAS __attribute__((address_space(1)))
#define LAS __attribute__((address_space(3)))
typedef unsigned short bf16;
typedef unsigned v4u __attribute__((ext_vector_type(4)));
typedef unsigned v2u __attribute__((ext_vector_type(2)));
typedef float f32x4 __attribute__((ext_vector_type(4)));
typedef float f32x2 __attribute__((ext_vector_type(2)));
typedef short bf16x8 __attribute__((ext_vector_type(8)));
typedef short bf16x4 __attribute__((ext_vector_type(4)));
typedef GAS unsigned gu32;
#define RLX_AGENT __ATOMIC_RELAXED, __HIP_MEMORY_SCOPE_AGENT
#define LDS_WAIT() asm volatile("s_waitcnt lgkmcnt(0)" ::: "memory")
#define VM_WAIT() asm volatile("s_waitcnt vmcnt(0)" ::: "memory")
__device__ __forceinline__ unsigned pk2(float lo, float hi) { return pg8::cvt_pk_bf16(lo, hi); }
__device__ __forceinline__ unsigned pk8(float a, float b, float c, float d) { int w = 0; w = __builtin_amdgcn_cvt_pk_fp8_f32(a, b, w, false); w = __builtin_amdgcn_cvt_pk_fp8_f32(c, d, w, true); return (unsigned)w; }
__device__ __forceinline__ float bf_lo(unsigned w) { return __uint_as_float(w << 16); }
__device__ __forceinline__ float bf_hi(unsigned w) { return __uint_as_float(w & 0xffff0000u); }
__device__ __forceinline__ float sigmoidf_(float x) { return __builtin_amdgcn_rcpf(1.0f + __builtin_amdgcn_exp2f(-1.4426950408889634f * x)); }
__device__ __forceinline__ f32x2 sigmoid2(f32x2 x) { const f32x2 t = x * -1.4426950408889634f; f32x2 e = {__builtin_amdgcn_exp2f(t.x), __builtin_amdgcn_exp2f(t.y)}; e = e + 1.0f; return (f32x2){__builtin_amdgcn_rcpf(e.x), __builtin_amdgcn_rcpf(e.y)}; }
__device__ __forceinline__ f32x2 gelu_tanh2(f32x2 x) {
    const f32x2 u = x * (x * x * 0.044715f + 1.0f); const f32x2 t = u * (0.7978845608028654f * 2.885390081777927f);
    f32x2 e = {__builtin_amdgcn_exp2f(t.x), __builtin_amdgcn_exp2f(t.y)}; e = e + 1.0f; const f32x2 r = {__builtin_amdgcn_rcpf(e.x), __builtin_amdgcn_rcpf(e.y)};
    return x - x * r; }
__device__ __forceinline__ float gelu_tanh(float x) { const float u = 0.7978845608028654f * (x + 0.044715f * x * x * x); const float e = __builtin_amdgcn_exp2f(2.885390081777927f * u); return x * (1.0f - __builtin_amdgcn_rcpf(e + 1.0f)); }

#define XB_TMO      128
#define XB_XCNT(j)  (256  + 64 * (j))
#define XB_XSUB(j)  (1280 + 64 * (j))
#define XB_XGEN(j)  (2304 + 64 * (j))
#define XB_TOP      3328
#define XB_TOPGEN   3392
#define XCD_BAR_WORDS 3456
#define XB_SPIN_CAP (1u << 18)
__device__ __forceinline__ unsigned xb_ld(unsigned* p)              { return __hip_atomic_load(p, __ATOMIC_RELAXED, __HIP_MEMORY_SCOPE_AGENT); }
__device__ __forceinline__ unsigned xb_add(unsigned* p, unsigned v) { return __hip_atomic_fetch_add(p, v, __ATOMIC_RELAXED, __HIP_MEMORY_SCOPE_AGENT); }
__device__ __forceinline__ unsigned xb_xcc_id() { return (unsigned)__builtin_amdgcn_s_getreg((3 << 11) | 20) & 0xFu; }
#define XB_SPIN(cond, bar) do { unsigned _sp = 0; while (cond) { __builtin_amdgcn_s_sleep(1); \
    if ((++_sp & 255u) == 0u) { if (xb_ld(&(bar)[XB_TMO])) break; if (_sp > XB_SPIN_CAP) { atomicAdd(&(bar)[XB_TMO], 1u); break; } } } } while (0)
struct XcdBarrier { unsigned* bar; unsigned x; volatile LAS unsigned* st; unsigned npart; };
__device__ __forceinline__ XcdBarrier xcd_barrier_post(unsigned* bar, volatile LAS unsigned* st, unsigned npart) {
    XcdBarrier b; b.bar = bar; b.x = xb_xcc_id(); b.st = st; b.npart = npart;
    if (threadIdx.x == 0) (void)xb_add(&bar[XB_XCNT(b.x)], 1u);
    return b;
}
__device__ __forceinline__ void xcd_barrier_complete(unsigned* bar, unsigned x, unsigned G, unsigned& nloc, unsigned& nx) {
    unsigned sum, cnt, mine, sp = 0u;
    for (;;) {
        sum = 0u; cnt = 0u; mine = 0u;
#pragma unroll
        for (unsigned j = 0; j < 16; ++j) { const unsigned c = xb_ld(&bar[XB_XCNT(j)]); sum += c; cnt += (c > 0u) ? 1u : 0u; mine = (j == x) ? c : mine; }
        if (sum == G) break;
        __builtin_amdgcn_s_sleep(1);
        if ((++sp & 255u) == 0u) { if (xb_ld(&bar[XB_TMO])) break; if (sp > XB_SPIN_CAP) { atomicAdd(&bar[XB_TMO], 1u); break; } }
    }
    nloc = mine > 0u ? mine : 1u; nx = cnt > 0u ? cnt : 1u;
}
__device__ __forceinline__ void xcd_barrier(const XcdBarrier& b) {
    asm volatile("s_waitcnt vmcnt(0)" ::: "memory");
    __syncthreads();
    if (threadIdx.x == 0) {
        unsigned* bar = b.bar;
        __builtin_amdgcn_s_waitcnt(0);
        unsigned nloc = b.st[0], nx = b.st[1];
        if (nloc == 0u) { xcd_barrier_complete(bar, b.x, b.npart, nloc, nx); b.st[0] = nloc; b.st[1] = nx; }
        const unsigned old = xb_add(&bar[XB_XSUB(b.x)], 1u);
        const unsigned gen = old / nloc;
        if (old + 1u == (gen + 1u) * nloc) {
            __builtin_amdgcn_fence(__ATOMIC_RELEASE, "agent");
            asm volatile("s_waitcnt vmcnt(0)" ::: "memory");
            const unsigned og = xb_add(&bar[XB_TOP], 1u);
            const unsigned tg = og / nx;
            if (og + 1u == (tg + 1u) * nx) xb_add(&bar[XB_TOPGEN], 1u);
            else XB_SPIN(xb_ld(&bar[XB_TOPGEN]) == tg, bar);
            __builtin_amdgcn_fence(__ATOMIC_ACQUIRE, "agent");
            xb_add(&bar[XB_XGEN(b.x)], 1u);
            asm volatile("s_waitcnt vmcnt(0)" ::: "memory");
        } else {
            XB_SPIN(xb_ld(&bar[XB_XGEN(b.x)]) == gen, bar);
            __builtin_amdgcn_fence(__ATOMIC_ACQUIRE, "agent");
            asm volatile("s_waitcnt vmcnt(0)" ::: "memory");
        }
    }
    __syncthreads();
}

struct Args { const float* in[34]; float* out; unsigned char* ws; int ph_lo, ph_hi; };
struct Frame {
    LAS unsigned char* lds;
    volatile LAS unsigned* MISC;
    gu32* ctl;
    unsigned char* ws;
    float* out;
    int tid, lane, wave, vcu, G;
};
__device__ __forceinline__ float wave_sum(float v) {
#pragma unroll
    for (int o = 1; o < 64; o <<= 1) v += __shfl_xor(v, o);
    return v;
}
__device__ __forceinline__ float wave_max(float v) {
#pragma unroll
    for (int o = 1; o < 64; o <<= 1) v = fmaxf(v, __shfl_xor(v, o));
    return v;
}

struct DenseOrder {
    const char* A; const char* Bt; size_t tstepA, tstepB; int nM, nN, nwg, G, c;
    __device__ void init(const void* A_, const void* Bt_, int M, int N, int lda, int ldb, int G_, int c_) { A = (const char*)A_; Bt = (const char*)Bt_; tstepA = (size_t)256 * lda * 2; tstepB = (size_t)256 * ldb * 2; nM = M / 256; nN = N / 256; nwg = nM * nN; G = G_; c = c_; }
    __device__ bool next(int i, pg8::Unit& u) const {
        const long L = (long)i * G + c; if (L >= nwg) return false;
        int wgid = (int)L; { const int q = nwg / 8, r = nwg % 8, xcd = wgid % 8, off = wgid / 8; wgid = (xcd < r ? xcd * (q + 1) : r * (q + 1) + (xcd - r) * q) + off; }
        const int nig = 8 * nN, gid = wgid / nig, fm = gid * 8, gsz = (nM - fm) < 8 ? (nM - fm) : 8;
        u.pm = fm + ((wgid % nig) % gsz); u.pn = (wgid % nig) / gsz; u.aux = 0; u.half = 0; u.r0 = 0; u.a = A + (size_t)u.pm * tstepA; u.b = Bt + (size_t)u.pn * tstepB; return true;
    }
    __device__ __forceinline__ void a_ready(const pg8::Unit&) const {}
    __device__ __forceinline__ void done(const pg8::Unit&) const {}
};
struct GroupOrder {
    const char* A; const char* Bt; size_t gstepA, gstepB, tstepA; int G, c;
    __device__ bool next(int i, pg8::Unit& u) const {
        const int L = i * G + c; if (L >= 128) return false;
        u.aux = L >> 1; u.pm = L & 1; u.pn = 0; u.half = 0; u.r0 = 0; u.a = A + (size_t)u.aux * gstepA + (size_t)u.pm * tstepA; u.b = Bt + (size_t)u.aux * gstepB; return true;
    }
    __device__ __forceinline__ void a_ready(const pg8::Unit&) const {}
    __device__ __forceinline__ void done(const pg8::Unit&) const {}
};
struct MoeOrder {
    const char* A; const char* Bt; size_t tstepA, tstepB, estepB; const LAS int* ul; const LAS unsigned* tokl; unsigned rowb;
    __device__ bool next(int i, pg8::Unit& u) const {
        if (i >= 12) return false; const int v = ul[4 * i], eh = ul[4 * i + 1]; if (!(v & 1)) return false;
        u.aux = eh & 255; u.half = eh >> 8; u.pm = ul[4 * i + 2]; u.pn = v >> 8; u.r0 = ul[4 * i + 3];
        u.a = A + (size_t)u.pm * tstepA; u.b = Bt + (size_t)u.aux * estepB + (size_t)u.pn * tstepB; return true;
    }
    __device__ __forceinline__ void a_ready(const pg8::Unit&) const {}
    __device__ __forceinline__ void done(const pg8::Unit&) const {}
};
__device__ __forceinline__ void moe_units(LAS int* ul, const volatile LAS unsigned* tc, int NT, int G, int c, int tid) {
    if (tid < 16) { const int L = tid * G + c; const int nfull = (int)tc[96 + 32] * NT, nh = (int)tc[129 + 32], total = nfull + nh * NT; int e = 0, pm = 0, pn = 0, hf = 0;
        if (L < nfull) {
            for (int k = 1; k < 32; ++k) { if (L >= (int)tc[96 + k] * NT) e = k; }
            const int f0 = (int)tc[96 + e], nmf = (int)tc[96 + e + 1] - f0, j = L - f0 * NT; pm = (int)tc[e] + j % nmf; pn = j / nmf;
        } else if (L < total) { const int Lh = L - nfull, hi = Lh % nh;
            for (int k = 1; k < 32; ++k) { if (hi >= (int)tc[129 + k]) e = k; }
            pm = (int)tc[e + 1] - 1; pn = Lh / nh; hf = 1; }
        ul[4 * tid] = (L < total ? 1 : 0) | (pn << 8); ul[4 * tid + 1] = e | (hf << 8); ul[4 * tid + 2] = pm; ul[4 * tid + 3] = (pm - (int)tc[e]) * 256; }
    __syncthreads();
}
struct MoeOrderW {
    const char* A; size_t tstepA; const float* W0; const float* W1; int updown; int NT, G, c; const volatile LAS unsigned* tc;
    __device__ bool next(int i, pg8::Unit& u) const {
        const int L = i * G + c; const int total = (int)tc[32] * NT; if (L >= total) return false;
        int e = 0;
#pragma unroll 1
        for (int k = 1; k < 32; ++k) { if (L >= (int)tc[k] * NT) e = k; }
        const int c0 = (int)tc[e], nm = (int)tc[e + 1] - c0, j = L - c0 * NT;
        u.aux = e; u.pm = c0 + j % nm; u.pn = j / nm; u.half = 0; u.r0 = 0; u.a = A + (size_t)u.pm * tstepA; u.b = nullptr; return true;
    }
    __device__ __forceinline__ __amdgpu_buffer_rsrc_t rsrcA() const { return __builtin_amdgcn_make_buffer_rsrc((void*)A, (short)0, MPAD * 2048 * 2, 0x00020000); }
    __device__ __forceinline__ unsigned aoff(const pg8::Unit& u) const { return (unsigned)u.pm * (unsigned)tstepA; }
    __device__ __forceinline__ __amdgpu_buffer_rsrc_t rsrc(int wid) const { return __builtin_amdgcn_make_buffer_rsrc((void*)((updown || wid < 4) ? W0 : W1), (short)0, 32 * 2048 * 2048 * 4, 0x00020000); }
    __device__ __forceinline__ unsigned woff(const pg8::Unit& u, int wid) const {
        return (unsigned)u.aux * (2048u * 2048u * 4u) + (updown ? (unsigned)(u.pn * 256 + wid * 32) : (unsigned)(u.pn * 128 + (wid & 3) * 32)) * 4u;
    }
};

#define EPI_LOOP_ROWS for (int ai = 0; ai < 2; ++ai) _Pragma("unroll") for (int m = 0; m < 4; ++m)
struct EpiInProj {
    static constexpr bool PERM = true, AFTER_DRAIN = false, MIDSCALE = false, LDSB = false, NST = 0;
    bf16* acat; bf16* qkv;
    __device__ __forceinline__ void operator()(const f32x4 (&acc)[2][2][4][2], const pg8::Unit& u, int wr, int wc, int fr, int fq) const {
        const int t = u.pn >> 2; const float sc = (t == 1) ? 0.125f : 1.0f;
#pragma unroll
        EPI_LOOP_ROWS { const int row = u.pm * 256 + ai * 128 + wr * 64 + m * 16 + fr;
#pragma unroll
            for (int bj = 0; bj < 2; ++bj) { const int cr = (u.pn & 3) * 256 + bj * 128 + wc * 32 + 8 * fq;
                const f32x4 v0 = acc[ai][bj][m][0] * sc, v1 = acc[ai][bj][m][1] * sc;
                v4u w; w.x = pk2(v0[0], v0[1]); w.y = pk2(v0[2], v0[3]); w.z = pk2(v1[0], v1[1]); w.w = pk2(v1[2], v1[3]);
                if (t == 3) { bf16* vt = qkv + (size_t)2 * SEQ * 1024 + (size_t)cr * SEQ + row;
                    vt[0 * SEQ] = (bf16)(w.x & 0xffff); vt[1 * SEQ] = (bf16)(w.x >> 16); vt[2 * SEQ] = (bf16)(w.y & 0xffff); vt[3 * SEQ] = (bf16)(w.y >> 16);
                    vt[4 * SEQ] = (bf16)(w.z & 0xffff); vt[5 * SEQ] = (bf16)(w.z >> 16); vt[6 * SEQ] = (bf16)(w.w & 0xffff); vt[7 * SEQ] = (bf16)(w.w >> 16); }
                else { bf16* dst = (t == 0) ? acat + ((size_t)((cr >> 4) * 512 + (row >> 4)) * 512 + (row & 15) * 16 + (cr & 15))
                                     : qkv + (size_t)(t - 1) * SEQ * 1024 + (size_t)row * 1024 + cr;
                    *(v4u*)dst = w; } } }
    }
};
struct EpiS5S {
    static constexpr bool PERM = false, AFTER_DRAIN = false, MIDSCALE = false, LDSB = false, NST = 0;
    float* S;
    __device__ __forceinline__ void operator()(const f32x4 (&acc)[2][2][4][2], const pg8::Unit& u, int wr, int wc, int fr, int fq) const {
#pragma unroll
        EPI_LOOP_ROWS { const int row = u.pm * 256 + ai * 128 + wr * 64 + m * 16 + fr; float* rp = S + ((size_t)u.aux * 512 + row) * 256 + wc * 32 + 4 * fq;
#pragma unroll
            for (int bj = 0; bj < 2; ++bj)
#pragma unroll
                for (int n = 0; n < 2; ++n) *(f32x4*)(rp + bj * 128 + n * 16) = acc[ai][bj][m][n]; }
    }
};
struct EpiS5Y {
    static constexpr bool PERM = true, AFTER_DRAIN = false, MIDSCALE = false, LDSB = false, NST = 0;
    bf16* YG;
    __device__ __forceinline__ void operator()(const f32x4 (&acc)[2][2][4][2], const pg8::Unit& u, int wr, int wc, int fr, int fq) const {
#pragma unroll
        EPI_LOOP_ROWS { const int c = u.pm * 256 + ai * 128 + wr * 64 + m * 16 + fr;
#pragma unroll
            for (int bj = 0; bj < 2; ++bj) { const int n = bj * 128 + wc * 32 + 8 * fq; const int tok = c * 16 + (n >> 4);
                const f32x4 v0 = acc[ai][bj][m][0], v1 = acc[ai][bj][m][1];
                const f32x2 g0 = gelu_tanh2((f32x2){v0[0], v0[1]}), g1 = gelu_tanh2((f32x2){v0[2], v0[3]}), g2 = gelu_tanh2((f32x2){v1[0], v1[1]}), g3 = gelu_tanh2((f32x2){v1[2], v1[3]});
                v4u w; w.x = pk2(g0.x, g0.y); w.y = pk2(g1.x, g1.y); w.z = pk2(g2.x, g2.y); w.w = pk2(g3.x, g3.y);
                *(v4u*)(YG + (size_t)tok * 1024 + u.aux * 16 + (n & 15)) = w; } }
    }
};
struct EpiGLU {
    static constexpr bool PERM = true, AFTER_DRAIN = false, MIDSCALE = false, LDSB = false, NST = 0;
    const bf16* YG; const float* bias; bf16* O; float* ssq;
    __device__ __forceinline__ void operator()(const f32x4 (&acc)[2][2][4][2], const pg8::Unit& u, int wr, int wc, int fr, int fq) const {
        const int col0 = u.pn * 256 + wc * 32 + 8 * fq;
        const f32x4 bv[2][2] = {{*(const f32x4*)(bias + col0), *(const f32x4*)(bias + col0 + 4)}, {*(const f32x4*)(bias + col0 + 128), *(const f32x4*)(bias + col0 + 132)}};
#pragma unroll
        for (int ai = 0; ai < 2; ++ai) {
            v4u yv[4][2];
#pragma unroll
            for (int m = 0; m < 4; ++m)
#pragma unroll
                for (int bj = 0; bj < 2; ++bj) yv[m][bj] = *(const v4u*)(YG + (size_t)(u.pm * 256 + ai * 128 + wr * 64 + m * 16 + fr) * 1024 + col0 + bj * 128);
            asm volatile("" ::: "memory");
#pragma unroll
            for (int m = 0; m < 4; ++m) { const int row = u.pm * 256 + ai * 128 + wr * 64 + m * 16 + fr; float sq = 0.f;
#pragma unroll
                for (int bj = 0; bj < 2; ++bj) { const int col = col0 + bj * 128; const v4u y = yv[m][bj];
                    const f32x4 v0 = acc[ai][bj][m][0] + bv[bj][0], v1 = acc[ai][bj][m][1] + bv[bj][1];
                    const f32x2 s0 = sigmoid2((f32x2){v0[0], v0[1]}), s1 = sigmoid2((f32x2){v0[2], v0[3]}), s2 = sigmoid2((f32x2){v1[0], v1[1]}), s3 = sigmoid2((f32x2){v1[2], v1[3]});
                    const f32x2 q0 = (f32x2){bf_lo(y.x), bf_hi(y.x)} * s0, q1 = (f32x2){bf_lo(y.y), bf_hi(y.y)} * s1, q2 = (f32x2){bf_lo(y.z), bf_hi(y.z)} * s2, q3 = (f32x2){bf_lo(y.w), bf_hi(y.w)} * s3;
                    const float o0 = q0.x, o1 = q0.y, o2 = q1.x, o3 = q1.y, o4 = q2.x, o5 = q2.y, o6 = q3.x, o7 = q3.y;
                    { const f32x2 ss = q0 * q0 + q1 * q1 + q2 * q2 + q3 * q3; sq += ss.x + ss.y; }
                    v4u w; w.x = pk2(o0, o1); w.y = pk2(o2, o3); w.z = pk2(o4, o5); w.w = pk2(o6, o7);
                    *(v4u*)(O + (size_t)row * 2048 + col) = w; }
                sq += __shfl_xor(sq, 16); sq += __shfl_xor(sq, 32);
                if (fq == 0) atomicAdd(ssq + 2 * row, sq); }
            asm volatile("" ::: "memory"); }
    }
};
struct EpiOut {
    static constexpr bool PERM = false, AFTER_DRAIN = false, MIDSCALE = true, LDSB = false, NST = 0;
    const float* X; float* X2; const float* ssq;
    __device__ __forceinline__ void mid(f32x4 (&acc)[2][2][4][2], const pg8::Unit& u, int wr, int wc, int fr, int fq) const {
#pragma unroll
        EPI_LOOP_ROWS { const int row = u.pm * 256 + ai * 128 + wr * 64 + m * 16 + fr; const f32x2 q = *(const f32x2*)(ssq + 2 * row);
            const float ratio = sqrtf((q.y * (1.0f / 1024.0f) + RMS_EPS) / (q.x * (1.0f / 1024.0f) + RMS_EPS));
#pragma unroll
            for (int bj = 0; bj < 2; ++bj)
#pragma unroll
                for (int n = 0; n < 2; ++n) acc[ai][bj][m][n] = acc[ai][bj][m][n] * ratio; }
    }
    __device__ __forceinline__ void operator()(const f32x4 (&acc)[2][2][4][2], const pg8::Unit& u, int wr, int wc, int fr, int fq) const {
#pragma unroll
        for (int ai = 0; ai < 2; ++ai) {
            f32x4 xv[4][2][2]; float r2[4];
#pragma unroll
            for (int m = 0; m < 4; ++m) { const int row = u.pm * 256 + ai * 128 + wr * 64 + m * 16 + fr; const size_t off = (size_t)row * 2048 + u.pn * 256 + wc * 32 + 4 * fq;
                r2[m] = ssq[2 * row + 1];
#pragma unroll
                for (int bj = 0; bj < 2; ++bj)
#pragma unroll
                    for (int n = 0; n < 2; ++n) xv[m][bj][n] = *(const f32x4*)(X + off + bj * 128 + n * 16); }
            asm volatile("" ::: "memory");
#pragma unroll
            for (int m = 0; m < 4; ++m) { const int row = u.pm * 256 + ai * 128 + wr * 64 + m * 16 + fr; const size_t off = (size_t)row * 2048 + u.pn * 256 + wc * 32 + 4 * fq;
                const float rr = 1.0f / sqrtf(r2[m] * (1.0f / 1024.0f) + RMS_EPS);
#pragma unroll
                for (int bj = 0; bj < 2; ++bj)
#pragma unroll
                    for (int n = 0; n < 2; ++n) *(f32x4*)(X2 + off + bj * 128 + n * 16) = xv[m][bj][n] + acc[ai][bj][m][n] * rr; }
            asm volatile("" ::: "memory"); }
    }
};
struct EpiGateUp {
    static constexpr bool PERM = true, AFTER_DRAIN = false, MIDSCALE = false, LDSB = false, NST = 0;
    const float* bg; const float* bu; bf16* ACT;
    __device__ __forceinline__ void operator()(const f32x4 (&acc)[2][2][4][2], const pg8::Unit& u, int wr, int wc, int fr, int fq) const {
        const int f0 = u.pn * 128 + wc * 32 + 8 * fq; const float* pg = bg + (size_t)u.aux * 2048 + f0; const float* pu = bu + (size_t)u.aux * 2048 + f0;
        const f32x4 g0 = *(const f32x4*)pg, g1 = *(const f32x4*)(pg + 4), u0 = *(const f32x4*)pu, u1 = *(const f32x4*)(pu + 4);
#pragma unroll
        EPI_LOOP_ROWS { const int row = u.pm * 256 + ai * 128 + wr * 64 + m * 16 + fr; float a[8];
#pragma unroll
            for (int n = 0; n < 2; ++n)
#pragma unroll
                for (int j = 0; j < 4; ++j) { const float g = fminf(acc[ai][0][m][n][j] + (n ? g1[j] : g0[j]), 7.0f); const float uu = fminf(fmaxf(acc[ai][1][m][n][j] + (n ? u1[j] : u0[j]), -7.0f), 7.0f);
                    a[n * 4 + j] = (uu + 1.0f) * (g * sigmoidf_(1.702f * g)); }
            v4u w; w.x = pk2(a[0], a[1]); w.y = pk2(a[2], a[3]); w.z = pk2(a[4], a[5]); w.w = pk2(a[6], a[7]);
            *(v4u*)(ACT + (size_t)row * 2048 + f0) = w; }
    }
};
struct EpiDown {
    static constexpr bool PERM = true, AFTER_DRAIN = false, MIDSCALE = false, LDSB = false, NST = 0;
    const float* bd; const float* rowgate; bf16* YS;
    __device__ __forceinline__ void operator()(const f32x4 (&acc)[2][2][4][2], const pg8::Unit& u, int wr, int wc, int fr, int fq) const {
#pragma unroll
        EPI_LOOP_ROWS { const int row = u.pm * 256 + ai * 128 + wr * 64 + m * 16 + fr; const float rg = rowgate[row];
#pragma unroll
            for (int bj = 0; bj < 2; ++bj) { const int col = u.pn * 256 + bj * 128 + wc * 32 + 8 * fq; const float* pb = bd + (size_t)u.aux * 2048 + col;
                const f32x4 v0 = (acc[ai][bj][m][0] + *(const f32x4*)pb) * rg, v1 = (acc[ai][bj][m][1] + *(const f32x4*)(pb + 4)) * rg;
                v4u w; w.x = pk2(v0[0], v0[1]); w.y = pk2(v0[2], v0[3]); w.z = pk2(v1[0], v1[1]); w.w = pk2(v1[2], v1[3]);
                *(v4u*)(YS + (size_t)row * 2048 + col) = w; } }
    }
};

struct EpiGateUp8 {
    static constexpr bool PERM = true, AFTER_DRAIN = false, MIDSCALE = false, LDSB = true; static constexpr int NST = 4;
    const float* bg; const float* bu; unsigned char* ACT; LAS unsigned char* BL;
    __device__ __forceinline__ void stage(const pg8::Unit& u, int ui, int wid, int lane) const {
        if (wid == 0 && lane < 32) { LAS unsigned char* t = BL + (ui & 1) * 1024; const size_t o = (size_t)u.aux * 2048 + u.pn * 128 + lane * 4;
            __builtin_amdgcn_global_load_lds((const unsigned*)(bg + o), (LAS unsigned*)t, 16, 0, 0); __builtin_amdgcn_global_load_lds((const unsigned*)(bu + o), (LAS unsigned*)(t + 512), 16, 0, 0); }
    }
    __device__ __forceinline__ void operator()(const f32x4 (&acc)[2][2][4][2], const pg8::Unit& u, int wr, int wc, int fr, int fq, int ui) const {
        const int f0 = u.pn * 128 + wc * 32 + 8 * fq; const LAS float* tb = (const LAS float*)(BL + (ui & 1) * 1024) + wc * 32 + 8 * fq;
        const f32x4 gbv[2] = {*(const LAS f32x4*)tb, *(const LAS f32x4*)(tb + 4)}, ubv[2] = {*(const LAS f32x4*)(tb + 128), *(const LAS f32x4*)(tb + 132)};
#pragma unroll
        EPI_LOOP_ROWS { if (u.half && ai == 1) continue; const int row = u.pm * 256 + ai * 128 + wr * 64 + m * 16 + fr; unsigned w[2];
#pragma unroll
            for (int n = 0; n < 2; ++n) { const f32x4 gb = gbv[n], ub = ubv[n]; float a[4];
#pragma unroll
                for (int j = 0; j < 4; j += 2) {
                    const f32x2 ag = {acc[ai][0][m][n][j], acc[ai][0][m][n][j + 1]}, au = {acc[ai][1][m][n][j], acc[ai][1][m][n][j + 1]};
                    f32x2 g = ag * 0.015625f + (f32x2){gb[j], gb[j + 1]}, uu = au * 0.015625f + (f32x2){ub[j], ub[j + 1]};
                    g.x = fminf(g.x, 7.0f); g.y = fminf(g.y, 7.0f); uu.x = fminf(fmaxf(uu.x, -7.0f), 7.0f); uu.y = fminf(fmaxf(uu.y, -7.0f), 7.0f);
                    const f32x2 t = g * (-1.702f * 1.4426950408889634f); f32x2 e = {__builtin_amdgcn_exp2f(t.x), __builtin_amdgcn_exp2f(t.y)}; e = e + 1.0f;
                    const f32x2 r = {__builtin_amdgcn_rcpf(e.x), __builtin_amdgcn_rcpf(e.y)};
                    const f32x2 o = (uu + 1.0f) * (g * r); a[j] = o.x; a[j + 1] = o.y; }
                w[n] = pk8(a[0], a[1], a[2], a[3]); }
            v2u o; o.x = w[0]; o.y = w[1];
            *(v2u*)(ACT + (size_t)row * 2048 + f0) = o;
            asm volatile("" ::: "memory"); }
    }
};
struct EpiDown8 {
    static constexpr bool PERM = true, AFTER_DRAIN = false, MIDSCALE = false, LDSB = true; static constexpr int NST = 8;
    const float* bd; const float* rowgate; unsigned char* YS; LAS unsigned char* BL;
    __device__ __forceinline__ void stage(const pg8::Unit& u, int ui, int wid, int lane) const {
        if (wid == 0) { LAS unsigned char* t = BL + (ui & 1) * 2048;
            __builtin_amdgcn_global_load_lds((const unsigned*)(bd + (size_t)u.aux * 2048 + u.pn * 256 + lane * 4), (LAS unsigned*)t, 16, 0, 0);
            __builtin_amdgcn_global_load_lds((const unsigned*)(rowgate + (size_t)u.aux * INVCAP + u.r0 + lane * 4), (LAS unsigned*)(t + 1024), 16, 0, 0); }
    }
    __device__ __forceinline__ void operator()(const f32x4 (&acc)[2][2][4][2], const pg8::Unit& u, int wr, int wc, int fr, int fq, int ui) const {
        const int col0 = u.pn * 256 + wc * 32 + 8 * fq; const LAS float* tb = (const LAS float*)(BL + (ui & 1) * 2048);
        const LAS float* pb = tb + wc * 32 + 8 * fq;
        const f32x4 bv[2][2] = {{*(const LAS f32x4*)pb, *(const LAS f32x4*)(pb + 4)}, {*(const LAS f32x4*)(pb + 128), *(const LAS f32x4*)(pb + 132)}};
        float rgv[2][4];
#pragma unroll
        for (int ai = 0; ai < 2; ++ai)
#pragma unroll
            for (int m = 0; m < 4; ++m) rgv[ai][m] = tb[256 + ai * 128 + wr * 64 + m * 16 + fr] * 16.0f;
        asm volatile("" ::: "memory");
#pragma unroll
        EPI_LOOP_ROWS { if (u.half && ai == 1) continue; const int lr = ai * 128 + wr * 64 + m * 16 + fr; const int row = u.pm * 256 + lr; const float rg = rgv[ai][m];
#pragma unroll
            for (int bj = 0; bj < 2; ++bj) { const int col = col0 + bj * 128;
                const f32x4 v0 = (acc[ai][bj][m][0] * 0.015625f + bv[bj][0]) * rg, v1 = (acc[ai][bj][m][1] * 0.015625f + bv[bj][1]) * rg;
                v2u w; w.x = pk8(v0[0], v0[1], v0[2], v0[3]); w.y = pk8(v1[0], v1[1], v1[2], v1[3]);
                *(v2u*)(YS + (size_t)row * 2048 + col) = w; } }
    }
};
struct EpiGateUpW {
    const float* bg; const float* bu; bf16* ACT;
    __device__ __forceinline__ void operator()(const f32x4 (&acc)[2][2][4][2], const pg8::Unit& u, int wr, int wc, int fr, int fq) const {
        const int f0 = u.pn * 128 + wc * 32 + 8 * fq; const float* pg = bg + (size_t)u.aux * 2048 + f0; const float* pu = bu + (size_t)u.aux * 2048 + f0;
#pragma unroll
        EPI_LOOP_ROWS { const int row = u.pm * 256 + ai * 128 + wr * 64 + m * 16 + fr; unsigned w[4];
#pragma unroll
            for (int n = 0; n < 2; ++n) { const f32x4 gb = *(const f32x4*)(pg + 4 * n), ub = *(const f32x4*)(pu + 4 * n); float a[4];
#pragma unroll
                for (int j = 0; j < 4; ++j) { const int rg = n ? ((j + 1) & 3) : j;
                    const float g = fminf(acc[ai][0][m][n][rg] + gb[j], 7.0f); const float uu = fminf(fmaxf(acc[ai][1][m][n][rg] + ub[j], -7.0f), 7.0f);
                    a[j] = (uu + 1.0f) * (g * sigmoidf_(1.702f * g)); }
                w[2 * n] = pk2(a[0], a[1]); w[2 * n + 1] = pk2(a[2], a[3]); }
            v4u o; o.x = w[0]; o.y = w[1]; o.z = w[2]; o.w = w[3];
            *(v4u*)(ACT + (size_t)row * 2048 + f0) = o;
            asm volatile("" ::: "memory"); }
    }
};
struct EpiDownW {
    const float* bd; const float* rowgate; bf16* YS;
    __device__ __forceinline__ void operator()(const f32x4 (&acc)[2][2][4][2], const pg8::Unit& u, int wr, int wc, int fr, int fq) const {
#pragma unroll
        EPI_LOOP_ROWS { const int row = u.pm * 256 + ai * 128 + wr * 64 + m * 16 + fr; const float rg = rowgate[row];
#pragma unroll
            for (int bj = 0; bj < 2; ++bj) { const int col = u.pn * 256 + bj * 128 + wc * 32 + 8 * fq; const float* pb = bd + (size_t)u.aux * 2048 + col;
                const f32x4 b0 = *(const f32x4*)pb, b1 = *(const f32x4*)(pb + 4); const f32x4 a0 = acc[ai][bj][m][0], a1 = acc[ai][bj][m][1];
                const f32x4 v0 = (a0 + b0) * rg, v1 = ((f32x4){a1[1], a1[2], a1[3], a1[0]} + b1) * rg;
                v4u w; w.x = pk2(v0[0], v0[1]); w.y = pk2(v0[2], v0[3]); w.z = pk2(v1[0], v1[1]); w.w = pk2(v1[2], v1[3]);
                *(v4u*)(YS + (size_t)row * 2048 + col) = w; } }
    }
};
__device__ __forceinline__ void tr_item(const float* __restrict__ W, int N, bf16* __restrict__ WT, int Kp, int k0, int n0, int drow0, int lane, const float* __restrict__ gk = nullptr) {
    const int nq = lane & 15, kb = lane >> 4;
    const float* src = W + (size_t)(k0 + kb * 16) * N + n0 + 4 * nq;
    f32x4 v[16];
#pragma unroll
    for (int i = 0; i < 16; ++i) { v[i] = *(const f32x4*)(src + (size_t)i * N); if (gk) v[i] = v[i] * gk[k0 + kb * 16 + i]; }
#pragma unroll
    for (int j = 0; j < 4; ++j) {
        v4u lo, hi;
        lo.x = pk2(v[0][j], v[1][j]); lo.y = pk2(v[2][j], v[3][j]); lo.z = pk2(v[4][j], v[5][j]); lo.w = pk2(v[6][j], v[7][j]);
        hi.x = pk2(v[8][j], v[9][j]); hi.y = pk2(v[10][j], v[11][j]); hi.z = pk2(v[12][j], v[13][j]); hi.w = pk2(v[14][j], v[15][j]);
        bf16* dst = WT + (size_t)(drow0 + 4 * nq + j) * Kp + k0 + kb * 16;
        *(v4u*)dst = lo; *(v4u*)(dst + 8) = hi;
    }
}
__device__ __forceinline__ void tr_item8(const float* __restrict__ W, int N, unsigned char* __restrict__ WT, int Kp, int k0, int n0, int drow0, int lane) {
    const int nq = lane & 7, kb = lane >> 3;
    const float* src = W + (size_t)(k0 + kb * 16) * N + n0 + 4 * nq;
    f32x4 v[16];
#pragma unroll
    for (int i = 0; i < 16; ++i) v[i] = __builtin_nontemporal_load((const f32x4*)(src + (size_t)i * N)) * 64.0f;
#pragma unroll
    for (int j = 0; j < 4; ++j) {
        v4u o; o.x = pk8(v[0][j], v[1][j], v[2][j], v[3][j]); o.y = pk8(v[4][j], v[5][j], v[6][j], v[7][j]); o.z = pk8(v[8][j], v[9][j], v[10][j], v[11][j]); o.w = pk8(v[12][j], v[13][j], v[14][j], v[15][j]);
        *(v4u*)(WT + (size_t)(drow0 + 4 * nq + j) * Kp + k0 + kb * 16) = o;
    }
}
__device__ __forceinline__ void rms_row_to_fp8(const float* __restrict__ xrow, const float* __restrict__ g, unsigned char* __restrict__ orow, int lane) {
    f32x4 v[8]; float s = 0.f;
#pragma unroll
    for (int j = 0; j < 8; ++j) { v[j] = *(const f32x4*)(xrow + 4 * lane + 256 * j); s += (v[j].x * v[j].x + v[j].y * v[j].y) + (v[j].z * v[j].z + v[j].w * v[j].w); }
    const float rstd = 1.0f / sqrtf(wave_sum(s) * (1.0f / 2048.0f) + RMS_EPS);
#pragma unroll
    for (int j = 0; j < 8; ++j) { const f32x4 gg = *(const f32x4*)(g + 4 * lane + 256 * j);
        *(unsigned*)(orow + 4 * lane + 256 * j) = pk8(v[j].x * rstd * gg.x, v[j].y * rstd * gg.y, v[j].z * rstd * gg.z, v[j].w * rstd * gg.w); }
}
__device__ __forceinline__ void rms_row_to_bf16(const float* __restrict__ xrow, const float* __restrict__ g, bf16* __restrict__ orow, int lane) {
    f32x4 v[8]; float s = 0.f;
#pragma unroll
    for (int j = 0; j < 8; ++j) { v[j] = *(const f32x4*)(xrow + 4 * lane + 256 * j); s += (v[j].x * v[j].x + v[j].y * v[j].y) + (v[j].z * v[j].z + v[j].w * v[j].w); }
    const float rstd = 1.0f / sqrtf(wave_sum(s) * (1.0f / 2048.0f) + RMS_EPS);
#pragma unroll
    for (int j = 0; j < 8; ++j) { const f32x4 gg = *(const f32x4*)(g + 4 * lane + 256 * j); v2u o; o.x = pk2(v[j].x * rstd * gg.x, v[j].y * rstd * gg.y); o.y = pk2(v[j].z * rstd * gg.z, v[j].w * rstd * gg.w);
        *(v2u*)(orow + 4 * lane + 256 * j) = o; }
}
__device__ __forceinline__ void s5_precompute(Frame& F, const Args& args, int g) {
    LAS f32x2* pw = (LAS f32x2*)(F.lds);
    LAS f32x2* bb = (LAS f32x2*)(F.lds + 17408);
    LAS f32x2* cc = (LAS f32x2*)(F.lds + 33792);
    LAS float* Kt = (LAS float*)(F.lds + 50176);
    const int tid = F.tid;
    if (tid < 128) {
        const int dir = tid >> 6, p = tid & 63;
        const float* LRE = dir ? args.in[10] : args.in[3]; const float* LIM = dir ? args.in[11] : args.in[4]; const float* LDT = dir ? args.in[12] : args.in[5];
        const float* BRE = dir ? args.in[13] : args.in[6]; const float* BIM = dir ? args.in[14] : args.in[7]; const float* CRE = dir ? args.in[15] : args.in[8]; const float* CIM = dir ? args.in[16] : args.in[9];
        const float lre = fminf(LRE[g * 64 + p], -1e-4f), lim = LIM[g * 64 + p], dt = expf(LDT[g]);
        const float mag = expf(lre * dt), ang = lim * dt; const float lbr = mag * cosf(ang), lbi = mag * sinf(ang);
        float pr = 1.f, pi = 0.f;
#pragma unroll 1
        for (int m = 0; m <= 16; ++m) { pw[(dir * 17 + m) * 64 + p] = (f32x2){pr, pi}; const float nr = pr * lbr - pi * lbi, ni = pr * lbi + pi * lbr; pr = nr; pi = ni; }
        const float nr = lbr - 1.0f, ni = lbi, den = lre * lre + lim * lim; const float cr = (nr * lre + ni * lim) / den, ci = (ni * lre - nr * lim) / den;
#pragma unroll 4
        for (int ch = 0; ch < 16; ++ch) { const float br = BRE[(size_t)(g * 64 + p) * 16 + ch], bi = BIM[(size_t)(g * 64 + p) * 16 + ch];
            bb[(dir * 64 + p) * 16 + ch] = (f32x2){cr * br - ci * bi, cr * bi + ci * br}; }
#pragma unroll 4
        for (int o = 0; o < 16; ++o) cc[(dir * 16 + o) * 64 + p] = (f32x2){CRE[(size_t)(g * 16 + o) * 64 + p], CIM[(size_t)(g * 16 + o) * 64 + p]};
    }
    __syncthreads();
#pragma unroll 1
    for (int it = 0; it < 16; ++it) { const int idx = tid + 512 * it; const int dir = idx >> 12, m = (idx >> 8) & 15, o = (idx >> 4) & 15, ch = idx & 15; float s = 0.f;
#pragma unroll 4
        for (int p = 0; p < 64; ++p) { const f32x2 c = cc[(dir * 16 + o) * 64 + p], w = pw[(dir * 17 + m) * 64 + p], b = bb[(dir * 64 + p) * 16 + ch];
            const float tr = c.x * w.x - c.y * w.y, ti = c.x * w.y + c.y * w.x; s += tr * b.x - ti * b.y; }
        Kt[idx] = s; }
    __syncthreads();
    bf16* Ms = (bf16*)(F.ws + WS_MS) + (size_t)g * 256 * 256; bf16* Mc = (bf16*)(F.ws + WS_MCAT) + (size_t)g * 256 * 512;
#pragma unroll 1
    for (int it = 0; it < 16; ++it) { const int q = tid + 512 * it; const int n = q >> 5, k0 = (q & 31) * 8; const int ip = k0 >> 4, ch0 = k0 & 15, dirn = n >> 7, ri = (n >> 6) & 1, p = n & 63; const int e = dirn == 0 ? 15 - ip : ip;
        const f32x2 w = pw[(dirn * 17 + e) * 64 + p]; float val[8];
#pragma unroll
        for (int j = 0; j < 8; ++j) { const f32x2 b = bb[(dirn * 64 + p) * 16 + ch0 + j]; val[j] = ri == 0 ? (w.x * b.x - w.y * b.y) : (w.x * b.y + w.y * b.x); }
        v4u o; o.x = pk2(val[0], val[1]); o.y = pk2(val[2], val[3]); o.z = pk2(val[4], val[5]); o.w = pk2(val[6], val[7]);
        *(v4u*)(Ms + (size_t)n * 256 + k0) = o; }
    const float* dvec = args.in[17];
#pragma unroll 1
    for (int it = 0; it < 32; ++it) { const int q = tid + 512 * it; const int n = q >> 6, k0 = (q & 63) * 8; const int i = n >> 4, o = n & 15; float val[8];
        if (k0 < 256) { const int ip = k0 >> 4, ch0 = k0 & 15;
#pragma unroll
            for (int j = 0; j < 8; ++j) { const int ch = ch0 + j; float v = 0.f;
                if (ip <= i) v += Kt[((0 * 16 + (i - ip)) * 16 + o) * 16 + ch];
                if (ip >= i) v += Kt[((1 * 16 + (ip - i)) * 16 + o) * 16 + ch];
                if (ip == i && ch == o) v += dvec[g * 16 + o];
                val[j] = v; }
        } else { const int kk = k0 - 256, sect = kk >> 6, p0 = kk & 63, dirn = sect >> 1; const int mm = dirn == 0 ? i + 1 : 16 - i;
#pragma unroll
            for (int j = 0; j < 8; ++j) { const int p = p0 + j; const f32x2 c = cc[(dirn * 16 + o) * 64 + p], w = pw[(dirn * 17 + mm) * 64 + p];
                val[j] = (sect & 1) ? -(c.x * w.y + c.y * w.x) : (c.x * w.x - c.y * w.y); } }
        v4u ov; ov.x = pk2(val[0], val[1]); ov.y = pk2(val[2], val[3]); ov.z = pk2(val[4], val[5]); ov.w = pk2(val[6], val[7]);
        *(v4u*)(Mc + (size_t)n * 512 + k0) = ov; }
    __syncthreads();
}
constexpr int I_IN = 32 * 64, I_GLU = 16 * 16, I_OUT = 32 * 32, I_E = 32 * 32;
constexpr int NITEMS2 = I_GLU + I_OUT + (MOE_MODE == 1 ? 0 : NE * 3 * I_E);
__device__ __forceinline__ void conv_item(Frame& F, const Args& args, int r) {
    if (r < I_GLU) { const int kb = r >> 4, nb = r & 15; tr_item(args.in[18], SW, (bf16*)(F.ws + WS_WTGLU), SW, kb * 64, nb * 64, nb * 64, F.lane); return; } r -= I_GLU;
    if (r < I_OUT) { const int kb = r >> 5, nb = r & 31; tr_item(args.in[23], DM, (bf16*)(F.ws + WS_WTOUT), DM, kb * 64, nb * 64, nb * 64, F.lane, (kb < 16 ? args.in[21] : args.in[22] - 1024)); return; } r -= I_OUT;
    const int e = r / (3 * I_E), r2 = r % (3 * I_E), which = r2 / I_E, r3 = r2 % I_E;
#if MOE_MODE == 2
    const int k0 = (r3 >> 6) * 128, n0 = (r3 & 63) * 32;
    if (which == 0) tr_item8(args.in[27] + (size_t)e * DM * DFF, DFF, (unsigned char*)(F.ws + WS_WTGU) + (size_t)e * 4096 * DM, DM, k0, n0, (n0 >> 7) * 256 + (n0 & 127), F.lane);
    else if (which == 1) tr_item8(args.in[29] + (size_t)e * DM * DFF, DFF, (unsigned char*)(F.ws + WS_WTGU) + (size_t)e * 4096 * DM, DM, k0, n0, (n0 >> 7) * 256 + 128 + (n0 & 127), F.lane);
    else tr_item8(args.in[31] + (size_t)e * DFF * DM, DM, (unsigned char*)(F.ws + WS_WTDN) + (size_t)e * DM * DFF, DFF, k0, n0, n0, F.lane);
#else
    const int kb = r3 >> 5, nb = r3 & 31, n0 = nb * 64;
    if (which == 0) tr_item(args.in[27] + (size_t)e * DM * DFF, DFF, (bf16*)(F.ws + WS_WTGU) + (size_t)e * 4096 * DM, DM, kb * 64, n0, (n0 >> 7) * 256 + (n0 & 127), F.lane);
    else if (which == 1) tr_item(args.in[29] + (size_t)e * DM * DFF, DFF, (bf16*)(F.ws + WS_WTGU) + (size_t)e * 4096 * DM, DM, kb * 64, n0, (n0 >> 7) * 256 + 128 + (n0 & 127), F.lane);
    else tr_item(args.in[31] + (size_t)e * DFF * DM, DM, (bf16*)(F.ws + WS_WTDN) + (size_t)e * DM * DFF, DFF, kb * 64, n0, n0, F.lane);
#endif
}
#if MOE_MODE == 2
__device__ __forceinline__ void moe_item_addr(Frame& F, int r, int& which, unsigned& soff, unsigned char*& dst) {
    const int e = r / (3 * I_E), r2 = r % (3 * I_E); which = r2 / I_E; const int r3 = r2 % I_E; const int k0 = (r3 >> 6) * 128, n0 = (r3 & 63) * 32; const int nq = F.lane & 7, kb = F.lane >> 3;
    unsigned char* WT = which == 2 ? (unsigned char*)(F.ws + WS_WTDN) + (size_t)e * DM * DFF : (unsigned char*)(F.ws + WS_WTGU) + (size_t)e * 4096 * DM;
    const int drow0 = which == 2 ? n0 : (n0 >> 7) * 256 + (which == 1 ? 128 : 0) + (n0 & 127);
    soff = (unsigned)e * (unsigned)(DM * DFF * 4) + (unsigned)((k0 + kb * 16) * DFF + n0 + 4 * nq) * 4u; dst = WT + (size_t)(k0 >> 7) * (size_t)((which == 2 ? DM : 4096) * 128) + (size_t)(drow0 + 4 * nq) * 128 + kb * 16;
}
__device__ __forceinline__ v4u cv_rsrc(const float* p) { const unsigned long long a = (unsigned long long)p; return (v4u){(unsigned)a, (unsigned)(a >> 32) & 0xffffu, (unsigned)(NE * DM * DFF * 4), 0x00020000u}; }
#define CV8_LOAD(v, rs, so) do { _Pragma("unroll") for (int i_ = 0; i_ < 16; ++i_) v[i_] = __builtin_bit_cast(f32x4, __builtin_amdgcn_raw_buffer_load_b128((rs), (so), i_ * (DFF * 4), 2)); } while (0)
#define CV8_STORE(v, dst) do { _Pragma("unroll") for (int j_ = 0; j_ < 4; ++j_) { v4u o_; o_.x = pk8(v[0][j_] * 64.f, v[1][j_] * 64.f, v[2][j_] * 64.f, v[3][j_] * 64.f); o_.y = pk8(v[4][j_] * 64.f, v[5][j_] * 64.f, v[6][j_] * 64.f, v[7][j_] * 64.f); \
        o_.z = pk8(v[8][j_] * 64.f, v[9][j_] * 64.f, v[10][j_] * 64.f, v[11][j_] * 64.f); o_.w = pk8(v[12][j_] * 64.f, v[13][j_] * 64.f, v[14][j_] * 64.f, v[15][j_] * 64.f); *(v4u*)((dst) + (size_t)j_ * 128) = o_; } } while (0)
#endif
__device__ __forceinline__ void conv_queue(Frame& F, const Args& args) {
    for (;;) { int base = 0; if (F.lane == 0) base = (int)__hip_atomic_fetch_add((unsigned*)(F.ctl + CW_Q), 8u, RLX_AGENT);
        base = __builtin_amdgcn_readfirstlane(base); if (base >= NITEMS2) break;
#if MOE_MODE == 2
        if (base >= I_GLU + I_OUT) {
            const v4u r0 = cv_rsrc(args.in[27]), r1 = cv_rsrc(args.in[29]), r2 = cv_rsrc(args.in[31]);
            int wa, wb; unsigned sa, sb; unsigned char* da; unsigned char* db; f32x4 va[16], vb[16];
#define CVA_LOAD(v, w, so) do { const v4u rs_ = (w) == 0 ? r0 : ((w) == 1 ? r1 : r2); \
        _Pragma("unroll") for (int i_ = 0; i_ < 16; ++i_) asm volatile("s_nop 4\n\tbuffer_load_dwordx4 %0, %1, %2, 0 offen nt" : "=&v"(v[i_]) : "v"((so) + (unsigned)(i_ * (DFF * 4))), "s"(rs_) : "memory"); } while (0)
#define CVA_WAIT(v, N) do { asm volatile("s_waitcnt vmcnt(" #N ")" : "+v"(v[0]), "+v"(v[1]), "+v"(v[2]), "+v"(v[3]), "+v"(v[4]), "+v"(v[5]), "+v"(v[6]), "+v"(v[7]) : : "memory"); \
        asm volatile("" : "+v"(v[8]), "+v"(v[9]), "+v"(v[10]), "+v"(v[11]), "+v"(v[12]), "+v"(v[13]), "+v"(v[14]), "+v"(v[15]) : : "memory"); } while (0)
            moe_item_addr(F, base - (I_GLU + I_OUT), wa, sa, da); CVA_LOAD(va, wa, sa);
#pragma unroll
            for (int i = 0; i < 8; i += 2) {
                moe_item_addr(F, base + i + 1 - (I_GLU + I_OUT), wb, sb, db); CVA_LOAD(vb, wb, sb);
                if (i == 0) CVA_WAIT(va, 16); else CVA_WAIT(va, 20);
                CV8_STORE(va, da);
                if (i + 2 < 8) { moe_item_addr(F, base + i + 2 - (I_GLU + I_OUT), wa, sa, da); CVA_LOAD(va, wa, sa); CVA_WAIT(vb, 20); } else CVA_WAIT(vb, 4);
                CV8_STORE(vb, db); }
#undef CVA_LOAD
#undef CVA_WAIT
            continue; }
#endif
#pragma unroll 1
        for (int i = 0; i < 8; ++i) if (base + i < NITEMS2) conv_item(F, args, base + i); }
}
__device__ __forceinline__ void p0_prologue(Frame& F, const Args& args) {
    const int gw = F.vcu * NWAVES + F.wave, NGW = F.G * NWAVES;
    for (int m = gw; m < SEQ; m += NGW) rms_row_to_bf16(args.in[0] + (size_t)m * DM, args.in[1], (bf16*)(F.ws + WS_XN) + (size_t)m * DM, F.lane);
    for (int i = gw * 64 + F.lane; i < DM * NE; i += NGW * 64) ((float*)(F.ws + WS_GW))[i] = args.in[24][i & 2047] * args.in[25][(size_t)(i & 2047) * 32 + (i >> 11)];
    for (int r = gw; r < I_IN; r += NGW) { const int kb = r >> 6, nb = r & 63; tr_item(args.in[2], NPROJ, (bf16*)(F.ws + WS_WTIN), DM, kb * 64, nb * 64, nb * 64, F.lane); }
}

constexpr int NA_VOFF = 65536, NA_RPOFF = 131072, NA_MGOFF = 133120;
__device__ __forceinline__ void na_task(Frame& F, const Args& args, int h, int rb) {
    LAS unsigned char* L = F.lds; LAS float* rp = (LAS float*)(F.lds + NA_RPOFF);
    const bf16* Qb = (const bf16*)(F.ws + WS_Q); const bf16* Kb = (const bf16*)(F.ws + WS_K); const bf16* Vb = (const bf16*)(F.ws + WS_V); bf16* Yb = (bf16*)(F.ws + WS_MIXED) + 1024; float* ssq = (float*)(F.ctl + CW_SSQ);
    const int tid = F.tid, lane = F.lane, fr = lane & 15, fq = lane >> 4, qt = F.wave & 3, kh = F.wave >> 2;
    const int r0 = rb * 8;
    const int kcS = tid >> 3, cS = tid & 7, dS = tid >> 3;
    const unsigned kdst = (unsigned)(kcS * 128 + ((cS ^ ((kcS >> 1) & 7)) << 4));
    const unsigned vdstb = (unsigned)(NA_VOFF + dS * 1024);
    const bf16* ksrc = Kb + (size_t)kcS * 1024 + h * 64 + cS * 8; const bf16* vsrc = Vb + (size_t)(h * 64 + dS) * SEQ + cS * 8;
    __syncthreads();
    { const int rs0 = r0 < 4 ? 0 : (r0 > 124 ? 120 : r0 - 4);
#pragma unroll 4
      for (int j = 0; j < 8; ++j) { const int ra = rs0 + j, slot = ra & 7;
          *(LAS v4u*)(L + slot * 8192 + kdst) = *(const v4u*)(ksrc + (size_t)ra * 64 * 1024);
          *(LAS v4u*)(L + vdstb + (((unsigned)(slot * 16 + 2 * cS) ^ (unsigned)((dS & 15) << 1)) << 3)) = *(const v4u*)(vsrc + ra * 64); } }
    for (int i = tid; i < 480; i += 512) rp[i] = ((i & 31) < 31) ? args.in[20][(size_t)h * 465 + (i >> 5) * 31 + (i & 31)] : -3.0e38f;
    __syncthreads();
    const int ct0 = qt == 0 ? 0 : (qt == 3 ? 1 : qt - 1);
    const int cq = qt * 16 + fr;
    const int cs = cq < 8 ? 0 : (cq > 56 ? 48 : cq - 8);
    unsigned dcb[3][4];
#pragma unroll
    for (int ct = 0; ct < 3; ++ct)
#pragma unroll
        for (int j = 0; j < 4; ++j) { const int kcc = (ct0 + ct) * 16 + fq * 4 + j; const bool valid = (kcc >= cs) && (kcc < cs + 16);
            int dc = kcc - cq; dc = dc < -15 ? -15 : (dc > 15 ? 15 : dc); dc += 15; dcb[ct][j] = valid ? (unsigned)dc * 4u : 124u; }
    bf16x8 qf[2];
#pragma unroll
    for (int ks = 0; ks < 2; ++ks) qf[ks] = *(const bf16x8*)(Qb + (size_t)(r0 * 64 + cq) * 1024 + h * 64 + ks * 32 + fq * 8);
#pragma unroll 1
    for (int st = 0; st < 8; ++st) {
        const int r = r0 + st; const int rs = r < 4 ? 0 : (r > 124 ? 120 : r - 4);
        const int rn = r + 1; const int rsn = rn < 4 ? 0 : (rn > 124 ? 120 : rn - 4); const bool pre = (st < 7) && (rsn != rs);
        v4u pk = {0u, 0u, 0u, 0u}, pv = {0u, 0u, 0u, 0u};
        if (pre) { const int ra = rsn + 7; pk = *(const v4u*)(ksrc + (size_t)ra * 64 * 1024); pv = *(const v4u*)(vsrc + ra * 64); }
        bf16x8 qn[2];
#pragma unroll
        for (int ks = 0; ks < 2; ++ks) qn[ks] = *(const bf16x8*)(Qb + (size_t)((st < 7 ? r + 1 : r) * 64 + cq) * 1024 + h * 64 + ks * 32 + fq * 8);
        f32x4 o[4] = {(f32x4){0.f, 0.f, 0.f, 0.f}, (f32x4){0.f, 0.f, 0.f, 0.f}, (f32x4){0.f, 0.f, 0.f, 0.f}, (f32x4){0.f, 0.f, 0.f, 0.f}};
        float mrun = -3.0e38f, lrun = 0.f;
#pragma unroll
        for (int kpi = 0; kpi < 2; ++kpi) { const int kp = kh * 2 + kpi;
            f32x4 sc[2][3], bs[2][3]; float mx = mrun;
#pragma unroll
            for (int k2 = 0; k2 < 2; ++k2) { const LAS unsigned char* rowp = (const LAS unsigned char*)rp + (rs + kp * 2 + k2 - r + 7) * 128;
#pragma unroll
                for (int ct = 0; ct < 3; ++ct)
#pragma unroll
                    for (int j = 0; j < 4; ++j) bs[k2][ct][j] = *(const LAS float*)(rowp + dcb[ct][j]); }
#pragma unroll
            for (int k2 = 0; k2 < 2; ++k2)
#pragma unroll
                for (int ct = 0; ct < 3; ++ct) {
                    const int kra = rs + kp * 2 + k2, slot = kra & 7; const int kc = (ct0 + ct) * 16 + fr;
                    const LAS unsigned char* kb = L + slot * 8192 + kc * 128; const int sw = (kc >> 1) & 7;
                    const bf16x8 k0 = *(const LAS bf16x8*)(kb + ((fq ^ sw) << 4)), k1 = *(const LAS bf16x8*)(kb + (((4 + fq) ^ sw) << 4));
                    f32x4 a = {0.f, 0.f, 0.f, 0.f};
                    a = __builtin_amdgcn_mfma_f32_16x16x32_bf16(k0, qf[0], a, 0, 0, 0);
                    a = __builtin_amdgcn_mfma_f32_16x16x32_bf16(k1, qf[1], a, 0, 0, 0);
                    a = a + bs[k2][ct];
                    mx = fmaxf(fmaxf(mx, fmaxf(a[0], a[1])), fmaxf(a[2], a[3]));
                    sc[k2][ct] = a; }
            mx = fmaxf(mx, __shfl_xor(mx, 16)); mx = fmaxf(mx, __shfl_xor(mx, 32));
            const float alpha = __expf(mrun - mx);
            float sum = 0.f;
#pragma unroll
            for (int k2 = 0; k2 < 2; ++k2)
#pragma unroll
                for (int ct = 0; ct < 3; ++ct)
#pragma unroll
                    for (int j = 0; j < 4; ++j) { const float p = __expf(sc[k2][ct][j] - mx); sc[k2][ct][j] = p; sum += p; }
            sum += __shfl_xor(sum, 16); sum += __shfl_xor(sum, 32);
            lrun = lrun * alpha + sum; mrun = mx;
            o[0] = o[0] * alpha; o[1] = o[1] * alpha; o[2] = o[2] * alpha; o[3] = o[3] * alpha;
#pragma unroll
            for (int pr = 0; pr < 3; ++pr) {
                const int ta = 2 * pr, tb = 2 * pr + 1; const int k2a = ta / 3, cta = ta % 3, k2b = tb / 3, ctb = tb % 3;
                const f32x4 pa = sc[k2a][cta], pb = sc[k2b][ctb];
                v4u pw; pw.x = pk2(pa[0], pa[1]); pw.y = pk2(pa[2], pa[3]); pw.z = pk2(pb[0], pb[1]); pw.w = pk2(pb[2], pb[3]);
                const bf16x8 pf = __builtin_bit_cast(bf16x8, pw);
                const unsigned cha = (unsigned)((((rs + kp * 2 + k2a) & 7) * 64 + (ct0 + cta) * 16 + fq * 4) >> 2), chb = (unsigned)((((rs + kp * 2 + k2b) & 7) * 64 + (ct0 + ctb) * 16 + fq * 4) >> 2);
#pragma unroll
                for (int d2 = 0; d2 < 4; ++d2) { const LAS unsigned char* vr = L + NA_VOFF + (d2 * 16 + fr) * 1024; const unsigned sx = (unsigned)(fr << 1);
                    const v2u va = *(const LAS v2u*)(vr + ((cha ^ sx) << 3)), vb = *(const LAS v2u*)(vr + ((chb ^ sx) << 3));
                    v4u vw; vw.x = va.x; vw.y = va.y; vw.z = vb.x; vw.w = vb.y;
                    o[d2] = __builtin_amdgcn_mfma_f32_16x16x32_bf16(__builtin_bit_cast(bf16x8, vw), pf, o[d2], 0, 0, 0); } }
        }
        LAS unsigned char* mg = L + NA_MGOFF + qt * 2176;
        if (kh == 1) {
#pragma unroll
            for (int d2 = 0; d2 < 4; ++d2) { v2u w; w.x = pk2(o[d2][0], o[d2][1]); w.y = pk2(o[d2][2], o[d2][3]); *(LAS v2u*)(mg + (d2 * 64 + lane) * 8) = w; }
            if (fq == 0) { *(LAS float*)(mg + 2048 + fr * 8) = mrun; *(LAS float*)(mg + 2048 + fr * 8 + 4) = lrun; }
        }
        qf[0] = qn[0]; qf[1] = qn[1];
        __syncthreads();
        if (kh == 0) {
            const float m1 = *(const LAS float*)(mg + 2048 + fr * 8), l1 = *(const LAS float*)(mg + 2048 + fr * 8 + 4);
            const float mm = fmaxf(mrun, m1), e0 = __expf(mrun - mm), e1 = __expf(m1 - mm); const float inv = 1.0f / (lrun * e0 + l1 * e1);
            float sq = 0.f;
#pragma unroll
            for (int d2 = 0; d2 < 4; ++d2) { const v2u w1 = *(const LAS v2u*)(mg + (d2 * 64 + lane) * 8);
                const f32x4 o1 = {bf_lo(w1.x), bf_hi(w1.x), bf_lo(w1.y), bf_hi(w1.y)}; const f32x4 ov = (o[d2] * e0 + o1 * e1) * inv;
                sq += (ov[0] * ov[0] + ov[1] * ov[1]) + (ov[2] * ov[2] + ov[3] * ov[3]);
                v2u w; w.x = pk2(ov[0], ov[1]); w.y = pk2(ov[2], ov[3]);
                *(v2u*)(Yb + (size_t)(r * 64 + cq) * 2048 + h * 64 + d2 * 16 + fq * 4) = w; }
            sq += __shfl_xor(sq, 16); sq += __shfl_xor(sq, 32);
            if (fq == 0) atomicAdd(ssq + 2 * (r * 64 + cq) + 1, sq);
        }
        if (pre) { const int slot = (rsn + 7) & 7;
            *(LAS v4u*)(L + slot * 8192 + kdst) = pk;
            *(LAS v4u*)(L + vdstb + (((unsigned)(slot * 16 + 2 * cS) ^ (unsigned)((dS & 15) << 1)) << 3)) = pv; }
        __syncthreads();
    }
}

__device__ __forceinline__ void s5_scan(Frame& F, const Args& args, int g, int dir) {
    LAS f32x2* E = (LAS f32x2*)(F.lds);
    const int p = F.lane, w = F.wave;
    const float* LRE = dir ? args.in[10] : args.in[3]; const float* LIM = dir ? args.in[11] : args.in[4]; const float* LDT = dir ? args.in[12] : args.in[5];
    const float lre = fminf(LRE[g * 64 + p], -1e-4f), lim = LIM[g * 64 + p], dt = expf(LDT[g]);
    const float mag = expf(lre * dt), ang = lim * dt; float ar = mag * cosf(ang), ai = mag * sinf(ang);
#pragma unroll
    for (int k = 0; k < 4; ++k) { const float nr = ar * ar - ai * ai, ni = 2.f * ar * ai; ar = nr; ai = ni; }
    float br = ar, bi = ai;
#pragma unroll
    for (int k = 0; k < 6; ++k) { const float nr = br * br - bi * bi, ni = 2.f * br * bi; br = nr; bi = ni; }
    const float* S = (const float*)(F.ws + WS_S5S) + (size_t)g * 512 * 256 + dir * 128 + p;
    bf16* X = (bf16*)(F.ws + WS_ACAT) + (size_t)g * 512 * 512 + 256 + dir * 128 + p;
    const int c0 = w * 64;
    float sre[64], sim[64];
#pragma unroll
    for (int j = 0; j < 64; ++j) { const int c = dir == 0 ? c0 + j : c0 + 63 - j; sre[j] = S[(size_t)c * 256]; sim[j] = S[(size_t)c * 256 + 64]; }
    float xr = 0.f, xi = 0.f;
#pragma unroll
    for (int j = 0; j < 64; ++j) { const float nr = ar * xr - ai * xi + sre[j], ni = ar * xi + ai * xr + sim[j]; xr = nr; xi = ni; }
    __syncthreads();
    E[w * 64 + p] = (f32x2){xr, xi};
    __syncthreads();
    xr = 0.f; xi = 0.f;
    if (dir == 0) { for (int ww = 0; ww < w; ++ww) { const f32x2 e = E[ww * 64 + p]; const float nr = br * xr - bi * xi + e.x, ni = br * xi + bi * xr + e.y; xr = nr; xi = ni; } }
    else { for (int ww = 7; ww > w; --ww) { const f32x2 e = E[ww * 64 + p]; const float nr = br * xr - bi * xi + e.x, ni = br * xi + bi * xr + e.y; xr = nr; xi = ni; } }
#pragma unroll
    for (int j = 0; j < 64; ++j) { const int c = dir == 0 ? c0 + j : c0 + 63 - j;
        X[(size_t)c * 512] = (bf16)(pk2(xr, 0.f) & 0xffff); X[(size_t)c * 512 + 64] = (bf16)(pk2(xi, 0.f) & 0xffff);
        const float nr = ar * xr - ai * xi + sre[j], ni = ar * xi + ai * xr + sim[j]; xr = nr; xi = ni; }
}

__device__ __forceinline__ void mixed_row(Frame& F, const Args& args, int tok) {
    const int lane = F.lane;
#pragma unroll
    for (int half = 0; half < 2; ++half) {
        const bf16* src = (const bf16*)(F.ws + (half == 0 ? WS_YSSM : WS_YNA)) + (size_t)tok * 1024 + lane * 8; const float* g = (half == 0 ? args.in[21] : args.in[22]) + lane * 8;
        const v4u a = *(const v4u*)src, b = *(const v4u*)(src + 512);
        float v[16] = {bf_lo(a.x), bf_hi(a.x), bf_lo(a.y), bf_hi(a.y), bf_lo(a.z), bf_hi(a.z), bf_lo(a.w), bf_hi(a.w), bf_lo(b.x), bf_hi(b.x), bf_lo(b.y), bf_hi(b.y), bf_lo(b.z), bf_hi(b.z), bf_lo(b.w), bf_hi(b.w)};
        float s = 0.f;
#pragma unroll
        for (int j = 0; j < 16; ++j) s += v[j] * v[j];
        const float rstd = 1.0f / sqrtf(wave_sum(s) * (1.0f / 1024.0f) + RMS_EPS);
        bf16* dst = (bf16*)(F.ws + WS_MIXED) + (size_t)tok * 2048 + half * 1024 + lane * 8;
#pragma unroll
        for (int q = 0; q < 2; ++q) { const f32x4 g0 = *(const f32x4*)(g + q * 512), g1 = *(const f32x4*)(g + q * 512 + 4);
            v4u o; o.x = pk2(v[q * 8 + 0] * rstd * g0.x, v[q * 8 + 1] * rstd * g0.y); o.y = pk2(v[q * 8 + 2] * rstd * g0.z, v[q * 8 + 3] * rstd * g0.w);
            o.z = pk2(v[q * 8 + 4] * rstd * g1.x, v[q * 8 + 5] * rstd * g1.y); o.w = pk2(v[q * 8 + 6] * rstd * g1.z, v[q * 8 + 7] * rstd * g1.w);
            *(v4u*)(dst + q * 512) = o; }
    }
}

constexpr int RT_PX = 2068;
__device__ __forceinline__ void router_group(Frame& F, const Args& args, int tg) {
    LAS float* X = (LAS float*)(F.lds);
    LAS float* logit = (LAS float*)(F.lds + 16 * RT_PX * 4);
    LAS float* rstdv = logit + 32 * 33;
    const int lane = F.lane, w = F.wave, i = lane & 15, kq = lane >> 4; const int t0 = tg * 32;
    const float* gb = (const float*)(F.ws + WS_GW) + (size_t)i * DM + 256 * w + 4 * kq;
    f32x4 gg[8];
#pragma unroll
    for (int j = 0; j < 8; ++j) gg[j] = *(const f32x4*)(args.in[24] + 4 * lane + 256 * j);
    __syncthreads();
#pragma unroll 1
    for (int p = 0; p < 2; ++p) {
#pragma unroll
        for (int rr = 0; rr < 2; ++rr) { const int r = 2 * w + rr, tok = t0 + 16 * p + r;
            const float* xrow = (const float*)(F.ws + WS_X2) + (size_t)tok * DM; f32x4 v[8]; float ss = 0.f;
#pragma unroll
            for (int j = 0; j < 8; ++j) { v[j] = *(const f32x4*)(xrow + 4 * lane + 256 * j); ss += (v[j].x * v[j].x + v[j].y * v[j].y) + (v[j].z * v[j].z + v[j].w * v[j].w); }
#pragma unroll
            for (int j = 0; j < 8; ++j) *(LAS f32x4*)(X + r * RT_PX + 4 * lane + 256 * j) = v[j];
            const float rstd = 1.0f / sqrtf(wave_sum(ss) * (1.0f / 2048.0f) + RMS_EPS);
            if (lane == 0) rstdv[16 * p + r] = rstd;
            unsigned char* orow = (unsigned char*)(F.ws + WS_XN) + (size_t)tok * DM;
#pragma unroll
            for (int j = 0; j < 8; ++j) *(unsigned*)(orow + 4 * lane + 256 * j) = pk8(v[j].x * rstd * gg[j].x, v[j].y * rstd * gg[j].y, v[j].z * rstd * gg[j].z, v[j].w * rstd * gg[j].w); }
        __syncthreads();
        f32x4 acc[2] = {(f32x4){0.f, 0.f, 0.f, 0.f}, (f32x4){0.f, 0.f, 0.f, 0.f}};
#pragma unroll 4
        for (int blk = 0; blk < 16; ++blk) {
            const f32x4 a = *(const LAS f32x4*)(X + i * RT_PX + 256 * w + blk * 16 + 4 * kq); f32x4 b[2];
#pragma unroll
            for (int nt = 0; nt < 2; ++nt) b[nt] = *(const f32x4*)(gb + (size_t)nt * 16 * DM + blk * 16);
#pragma unroll
            for (int sI = 0; sI < 4; ++sI)
#pragma unroll
                for (int nt = 0; nt < 2; ++nt) acc[nt] = __builtin_amdgcn_mfma_f32_16x16x4f32(a[sI], b[nt][sI], acc[nt], 0, 0, 0);
        }
        __syncthreads();
#pragma unroll
        for (int nt = 0; nt < 2; ++nt)
#pragma unroll
            for (int rg = 0; rg < 4; ++rg) X[(w * 16 + kq * 4 + rg) * 33 + 16 * nt + i] = acc[nt][rg];
        __syncthreads();
        { const int tokr = F.tid >> 5, e = F.tid & 31; float sm = 0.f;
#pragma unroll
          for (int ww = 0; ww < 8; ++ww) sm += X[(ww * 16 + tokr) * 33 + e];
          logit[(16 * p + tokr) * 33 + e] = sm; }
        __syncthreads();
    }
    if (w == 0 && lane < 32) {
        const int tok = t0 + lane;
        float l[32]; const float rstd = rstdv[lane];
#pragma unroll
        for (int e = 0; e < 32; ++e) l[e] = logit[lane * 33 + e] * rstd + args.in[26][e];
        int sel[4]; float val[4];
#pragma unroll
        for (int k = 0; k < 4; ++k) { float best = -3.0e38f; int bi = 0;
#pragma unroll
            for (int e = 0; e < 32; ++e) { if (l[e] > best) { best = l[e]; bi = e; } }
            sel[k] = bi; val[k] = best;
#pragma unroll
            for (int e = 0; e < 32; ++e) l[e] = (e == bi) ? -3.0e38f : l[e]; }
        float gsum = 0.f; float gt[4];
#pragma unroll
        for (int k = 0; k < 4; ++k) { gt[k] = __expf(val[k] - val[0]); gsum += gt[k]; }
        int rank[4] = {0, 0, 0, 0}; unsigned mycnt = 0u;
#pragma unroll 4
        for (int e = 0; e < 32; ++e) { const bool has = (sel[0] == e) | (sel[1] == e) | (sel[2] == e) | (sel[3] == e);
            const unsigned long long mask = __ballot(has);
            const int rk = __popcll(mask & ((1ull << lane) - 1ull));
#pragma unroll
            for (int k = 0; k < 4; ++k) rank[k] = (sel[k] == e) ? rk : rank[k];
            mycnt = (lane == e) ? (unsigned)__popcll(mask) : mycnt; }
        const unsigned mybase = __hip_atomic_fetch_add((unsigned*)(F.ctl + CW_CNT + 64 * lane), mycnt, RLX_AGENT);
#pragma unroll
        for (int k = 0; k < 4; ++k) rank[k] += __shfl((int)mybase, sel[k]);
        int* RE = (int*)(F.ws + WS_RE); int* RR = (int*)(F.ws + WS_RR); float* RG = (float*)(F.ws + WS_RG);
#pragma unroll
        for (int k = 0; k < 4; ++k) { RE[tok * 4 + k] = sel[k]; RR[tok * 4 + k] = rank[k]; RG[tok * 4 + k] = gt[k] / gsum;
            ((int*)(F.ws + WS_INVT))[sel[k] * INVCAP + rank[k]] = tok; ((float*)(F.ws + WS_INVG))[sel[k] * INVCAP + rank[k]] = gt[k] / gsum; }
    }
}
__device__ __forceinline__ void moe_table(Frame& F) {
    __syncthreads();
    if (F.tid < 64) {
        const int lane = F.tid; const unsigned c = lane < 32 ? __hip_atomic_load((unsigned*)(F.ctl + CW_CNT + 64 * (lane & 31)), RLX_AGENT) : 0u;
        const unsigned tiles = (c + 255u) >> 8; const unsigned half = (tiles > 0u && c - (tiles - 1u) * 256u <= 128u) ? 1u : 0u; const unsigned full = tiles - half;
        unsigned incl = tiles, inf = full, inh = half;
#pragma unroll
        for (int off = 1; off < 32; off <<= 1) { const unsigned t = (unsigned)__shfl_up((int)incl, off), tf = (unsigned)__shfl_up((int)inf, off), th = (unsigned)__shfl_up((int)inh, off); if (lane >= off) { incl += t; inf += tf; inh += th; } }
        if (lane < 32) { F.MISC[64 + lane] = incl - tiles; F.MISC[128 + lane] = c; F.MISC[160 + lane] = inf - full; F.MISC[193 + lane] = inh - half;
            if (lane == 31) { F.MISC[64 + 32] = incl; F.MISC[160 + 32] = inf; F.MISC[193 + 32] = inh; } }
    }
    __syncthreads();
}
__device__ __forceinline__ void gather_row(Frame& F, int tok) {
    const int lane = F.lane;
    const int* RE = (const int*)(F.ws + WS_RE); const int* RR = (const int*)(F.ws + WS_RR); const float* RG = (const float*)(F.ws + WS_RG);
    const bf16* src = (const bf16*)(F.ws + WS_XN) + (size_t)tok * DM + lane * 8;
    v4u v[4];
#pragma unroll
    for (int j = 0; j < 4; ++j) v[j] = *(const v4u*)(src + 512 * j);
#pragma unroll
    for (int k = 0; k < 4; ++k) { const int e = RE[tok * 4 + k]; const int dest = (int)F.MISC[64 + e] * 256 + RR[tok * 4 + k];
        bf16* dst = (bf16*)(F.ws + WS_XS) + (size_t)dest * DM + lane * 8;
#pragma unroll
        for (int j = 0; j < 4; ++j) *(v4u*)(dst + 512 * j) = v[j];
        if (lane == 0) { ((int*)(F.ws + WS_POS))[tok * 4 + k] = dest; ((float*)(F.ws + WS_ROWGATE))[dest] = RG[tok * 4 + k]; } }
}
__device__ __forceinline__ void gather_row8(Frame& F, int tok) {
    const int lane = F.lane;
    const int* RE = (const int*)(F.ws + WS_RE); const int* RR = (const int*)(F.ws + WS_RR); const float* RG = (const float*)(F.ws + WS_RG);
    const unsigned char* src = (const unsigned char*)(F.ws + WS_XN) + (size_t)tok * DM + lane * 16;
    const v4u v0 = *(const v4u*)src, v1 = *(const v4u*)(src + 1024);
#pragma unroll
    for (int k = 0; k < 4; ++k) { const int e = RE[tok * 4 + k]; const int dest = (int)F.MISC[64 + e] * 256 + RR[tok * 4 + k];
        unsigned char* dst = (unsigned char*)(F.ws + WS_XS) + (size_t)dest * DM + lane * 16;
        *(v4u*)dst = v0; *(v4u*)(dst + 1024) = v1;
        if (lane == 0) { ((int*)(F.ws + WS_POS))[tok * 4 + k] = dest; ((float*)(F.ws + WS_ROWGATE))[dest] = RG[tok * 4 + k]; } }
}
__device__ __forceinline__ void final_rows(Frame& F, const Args& args, int gw, int NGW) {
    const int lane = F.lane; const int* RE = (const int*)(F.ws + WS_RE); const int* RR = (const int*)(F.ws + WS_RR);
    const float* g = args.in[33]; f32x4 gg[8];
#pragma unroll
    for (int j = 0; j < 4; ++j) { gg[2 * j] = *(const f32x4*)(g + 512 * j + lane * 8); gg[2 * j + 1] = *(const f32x4*)(g + 512 * j + lane * 8 + 4); }
    if (gw >= SEQ) return;
    v4u re = *(const v4u*)(RE + gw * 4), rr = *(const v4u*)(RR + gw * 4);
#pragma unroll 1
    for (int tok = gw; tok < SEQ; tok += NGW) {
        const float* xrow = (const float*)(F.ws + WS_X2) + (size_t)tok * DM;
        f32x4 xa[8]; v2u y[4][4];
#pragma unroll
        for (int j = 0; j < 4; ++j) { xa[2 * j] = *(const f32x4*)(xrow + 512 * j + lane * 8); xa[2 * j + 1] = *(const f32x4*)(xrow + 512 * j + lane * 8 + 4); }
#pragma unroll
        for (int k = 0; k < 4; ++k) { const int dest = (int)F.MISC[64 + re[k]] * 256 + (int)rr[k]; const unsigned char* yr = (const unsigned char*)(F.ws + WS_YS) + (size_t)dest * DM + lane * 8;
#pragma unroll
            for (int j = 0; j < 4; ++j) y[k][j] = *(const v2u*)(yr + 512 * j); }
        { const int tn = tok + NGW < SEQ ? tok + NGW : tok; re = *(const v4u*)(RE + tn * 4); rr = *(const v4u*)(RR + tn * 4); }
        float v[32];
#pragma unroll
        for (int j = 0; j < 4; ++j) { const f32x4 a = xa[2 * j], b = xa[2 * j + 1];
            v[j * 8 + 0] = a.x; v[j * 8 + 1] = a.y; v[j * 8 + 2] = a.z; v[j * 8 + 3] = a.w; v[j * 8 + 4] = b.x; v[j * 8 + 5] = b.y; v[j * 8 + 6] = b.z; v[j * 8 + 7] = b.w; }
#pragma unroll
        for (int k = 0; k < 4; ++k)
#pragma unroll
            for (int j = 0; j < 4; ++j) { const v2u yy = y[k][j];
                const f32x2 a0 = __builtin_amdgcn_cvt_pk_f32_fp8((int)yy.x, false), a1 = __builtin_amdgcn_cvt_pk_f32_fp8((int)yy.x, true), a2 = __builtin_amdgcn_cvt_pk_f32_fp8((int)yy.y, false), a3 = __builtin_amdgcn_cvt_pk_f32_fp8((int)yy.y, true);
                v[j * 8 + 0] += a0.x * 0.0625f; v[j * 8 + 1] += a0.y * 0.0625f; v[j * 8 + 2] += a1.x * 0.0625f; v[j * 8 + 3] += a1.y * 0.0625f; v[j * 8 + 4] += a2.x * 0.0625f; v[j * 8 + 5] += a2.y * 0.0625f; v[j * 8 + 6] += a3.x * 0.0625f; v[j * 8 + 7] += a3.y * 0.0625f; }
        float s = 0.f;
#pragma unroll
        for (int j = 0; j < 32; ++j) s += v[j] * v[j];
        const float rstd = 1.0f / sqrtf(wave_sum(s) * (1.0f / 2048.0f) + RMS_EPS);
        float* orow = F.out + (size_t)tok * DM;
#pragma unroll
        for (int j = 0; j < 4; ++j) { const f32x4 g0 = gg[2 * j], g1 = gg[2 * j + 1];
            *(f32x4*)(orow + 512 * j + lane * 8) = (f32x4){v[j * 8 + 0] * rstd * g0.x, v[j * 8 + 1] * rstd * g0.y, v[j * 8 + 2] * rstd * g0.z, v[j * 8 + 3] * rstd * g0.w};
            *(f32x4*)(orow + 512 * j + lane * 8 + 4) = (f32x4){v[j * 8 + 4] * rstd * g1.x, v[j * 8 + 5] * rstd * g1.y, v[j * 8 + 6] * rstd * g1.z, v[j * 8 + 7] * rstd * g1.w}; }
    }
}

__global__ void __launch_bounds__(NWAVES * 64, 2) fwd_kernel(Args args) {
    extern __shared__ __attribute__((aligned(16))) unsigned char lds[];
    Frame F;
    F.lds = (LAS unsigned char*)lds;
    F.MISC = (volatile LAS unsigned*)(F.lds + MISC_OFF);
    F.tid = threadIdx.x; F.lane = F.tid & 63; F.wave = __builtin_amdgcn_readfirstlane(F.tid >> 6);
    F.G = gridDim.x; { const int bx = blockIdx.x; F.vcu = (F.G % 8 == 0) ? (bx % 8) * (F.G / 8) + bx / 8 : bx; }
    F.ws = args.ws; F.ctl = (gu32*)(args.ws + WS_CTL); F.out = args.out;
    for (int u = F.tid; u < 256; u += NWAVES * 64) F.MISC[u] = 0u;
    __syncthreads();
    XcdBarrier bar; bar.bar = (unsigned*)(F.ctl + CW_BAR); bar.x = 0; bar.st = nullptr; bar.npart = F.G;
    if (N_LAUNCHES == 1) bar = xcd_barrier_post((unsigned*)(F.ctl + CW_BAR), F.MISC + 8, (unsigned)F.G);
    const bool split = (N_LAUNCHES == 1) && (F.G == 256); const bool s5wg = blockIdx.x < 128;
    XcdBarrier bar2 = bar; if (split && s5wg) bar2 = xcd_barrier_post((unsigned*)(F.ctl + CW_BAR2), F.MISC + 10, 128u);
#define SUB_BAR(k) do { if (split) { if (s5wg) xcd_barrier(bar2); } else if (BOTH(k)) GRID_BAR(); } while (0)
#define GRID_BAR() do { if (N_LAUNCHES == 1) xcd_barrier(bar); } while (0)
    const int lo = args.ph_lo, hi = args.ph_hi;
#ifndef PHASE_MASK
#define PHASE_MASK 0x1fff
#endif
#define IN(k) (((PHASE_MASK >> (k)) & 1) && lo <= (k) && (k) < hi)
#define BOTH(k) (IN(k) && IN((k) + 1))
#ifndef REP_MASK
#define REP_MASK 0
#endif
#define PH(k) if (IN(k))
    const int gw = F.vcu * NWAVES + F.wave, NGW = F.G * NWAVES;
    unsigned char* ws = args.ws;

    PH(0) { p0_prologue(F, args); if (!split && blockIdx.x < NG) s5_precompute(F, args, (int)blockIdx.x); if (BOTH(0)) GRID_BAR(); }
    PH(1) {
        constexpr int NGW1 = 104;
        if (!split || (int)blockIdx.x < NGW1) {
            pg8::Gemm g{DM, DM, DM}; DenseOrder S; S.init(ws + WS_XN, ws + WS_WTIN, SEQ, NPROJ, DM, DM, split ? NGW1 : F.G, (int)blockIdx.x);
            EpiInProj E{(bf16*)(ws + WS_ACAT), (bf16*)(ws + WS_Q)};
            pg8::gemm_phase<EpiInProj, DenseOrder, true, true>(F.lds + RING_OFF, g, S, E);
        } else if ((int)blockIdx.x - NGW1 < NG) s5_precompute(F, args, (int)blockIdx.x - NGW1);
        conv_queue(F, args);
        if (BOTH(1)) GRID_BAR();
    }
    PH(2) {
        if (!split || s5wg) { pg8::Gemm g{256, 512, 256}; GroupOrder S{(const char*)(ws + WS_ACAT), (const char*)(ws + WS_MS), (size_t)512 * 512 * 2, (size_t)256 * 256 * 2, (size_t)256 * 512 * 2, F.G, (int)blockIdx.x};
          EpiS5S E{(float*)(ws + WS_S5S)};
          pg8::gemm_phase<EpiS5S, GroupOrder, true, true>(F.lds + RING_OFF, g, S, E); }
        if (!split) { for (int u = F.vcu; u < 256; u += F.G) na_task(F, args, u >> 4, u & 15); }
        else if (!s5wg) { for (int u = (int)blockIdx.x - 128; u < 256; u += 128) na_task(F, args, u >> 4, u & 15); }
        SUB_BAR(2);
    }
    PH(3) { if (blockIdx.x < 128) s5_scan(F, args, (int)blockIdx.x >> 1, (int)blockIdx.x & 1); SUB_BAR(3); }
    PH(4) {
        pg8::Gemm g{512, 512, 512}; GroupOrder S{(const char*)(ws + WS_ACAT), (const char*)(ws + WS_MCAT), (size_t)512 * 512 * 2, (size_t)256 * 512 * 2, (size_t)256 * 512 * 2, F.G, (int)blockIdx.x};
        EpiS5Y E{(bf16*)(ws + WS_YG)};
        pg8::gemm_phase<EpiS5Y, GroupOrder, true, true>(F.lds + RING_OFF, g, S, E);
        SUB_BAR(4);
    }
    PH(5) {
        pg8::Gemm g{SW, SW, SW}; DenseOrder S; S.init(ws + WS_YG, ws + WS_WTGLU, SEQ, SW, SW, SW, F.G, (int)blockIdx.x);
        EpiGLU E{(const bf16*)(ws + WS_YG), args.in[19], (bf16*)(ws + WS_MIXED), (float*)(F.ctl + CW_SSQ)};
        pg8::gemm_phase<EpiGLU, DenseOrder, true, true>(F.lds + RING_OFF, g, S, E);
        if (BOTH(5)) GRID_BAR();
    }
    PH(7) {
        pg8::Gemm g{DM, DM, DM}; DenseOrder S; S.init(ws + WS_MIXED, ws + WS_WTOUT, SEQ, DM, DM, DM, F.G, (int)blockIdx.x);
        EpiOut E{args.in[0], (float*)(ws + WS_X2), (const float*)(F.ctl + CW_SSQ)};
        pg8::gemm_phase<EpiOut, DenseOrder, true, true>(F.lds + RING_OFF, g, S, E);
        if (BOTH(7)) GRID_BAR();
    }
    PH(8) {
        for (int tg = (int)blockIdx.x; tg < SEQ / 32; tg += F.G) router_group(F, args, tg);
        if (BOTH(8)) GRID_BAR();
    }
#if MOE_MODE == 2
#else
    PH(9) { moe_table(F); for (int m = gw; m < SEQ; m += NGW) gather_row(F, m); if (BOTH(9)) GRID_BAR(); }
#endif
    PH(10) {
        moe_table(F);
#if MOE_MODE == 2
        LAS int* ul = (LAS int*)(F.lds + RING_BYTES); moe_units(ul, F.MISC + 64, 16, F.G, F.vcu, F.tid);
        LAS unsigned* tokl = (LAS unsigned*)(F.lds + RING_BYTES + 256);
        { const int* INVT = (const int*)(ws + WS_INVT);
          unsigned tv[6]; bool okv[6];
#pragma unroll
          for (int q = 0; q < 6; ++q) { const int idx = q * 512 + F.tid, i = idx >> 8, r = idx & 255; const int v = ul[4 * i], e = ul[4 * i + 1] & 255, rank = ul[4 * i + 3] + r;
              okv[q] = (v & 1) && rank < (int)F.MISC[128 + e]; tv[q] = (unsigned)INVT[okv[q] ? e * INVCAP + rank : 0]; }
#pragma unroll
          for (int q = 0; q < 6; ++q) tokl[q * 512 + F.tid] = okv[q] ? tv[q] : 0u;
          __syncthreads(); }
        pg8::Gemm g{DM / 2, DM / 2, 64, 4096 * 128}; MoeOrder S{(const char*)(ws + WS_XN), (const char*)(ws + WS_WTGU), (size_t)256 * DM, (size_t)256 * 128, (size_t)4096 * DM, ul, tokl, (unsigned)DM};
        EpiGateUp8 E{args.in[28], args.in[30], (unsigned char*)(ws + WS_ACT), F.lds + RING_BYTES + 12544};
        pg8::gemm_phase<EpiGateUp8, MoeOrder, true, true, true, true, true>(F.lds + RING_OFF, g, S, E);
#elif MOE_MODE == 1
        pg8::Gemm g{DM, DM, DFF}; MoeOrderW S{(const char*)(ws + WS_XS), (size_t)256 * DM * 2, args.in[27], args.in[29], 0, 16, F.G, F.vcu, F.MISC + 64};
        EpiGateUpW E{args.in[28], args.in[30], (bf16*)(ws + WS_ACT)};
        pg8::gemm_phase_w32<EpiGateUpW, MoeOrderW>(F.lds + RING_OFF, g, S, E);
#else
        pg8::Gemm g{DM, DM, DM}; MoeOrder S{(const char*)(ws + WS_XS), (const char*)(ws + WS_WTGU), (size_t)256 * DM * 2, (size_t)256 * DM * 2, (size_t)4096 * DM * 2, 16, F.G, F.vcu, F.MISC + 64};
        EpiGateUp E{args.in[28], args.in[30], (bf16*)(ws + WS_ACT)};
        pg8::gemm_phase<EpiGateUp, MoeOrder, true, true>(F.lds + RING_OFF, g, S, E);
#endif
        if (BOTH(10)) GRID_BAR();
    }
    PH(11) {
        if (N_LAUNCHES != 1) moe_table(F);
#if MOE_MODE == 2
        LAS int* ul = (LAS int*)(F.lds + RING_BYTES); moe_units(ul, F.MISC + 64, 8, F.G, F.vcu, F.tid);
        pg8::Gemm g{DFF / 2, DFF / 2, 64, DM * 128}; MoeOrder S{(const char*)(ws + WS_ACT), (const char*)(ws + WS_WTDN), (size_t)256 * DFF, (size_t)256 * 128, (size_t)DM * DFF, ul, nullptr, 0u};
        EpiDown8 E{args.in[32], (const float*)(ws + WS_INVG), (unsigned char*)(ws + WS_YS), F.lds + RING_BYTES + 256};
        pg8::gemm_phase<EpiDown8, MoeOrder, true, true, true, true>(F.lds + RING_OFF, g, S, E);
#elif MOE_MODE == 1
        pg8::Gemm g{DFF, DFF, DM}; MoeOrderW S{(const char*)(ws + WS_ACT), (size_t)256 * DFF * 2, args.in[31], args.in[31], 1, 8, F.G, F.vcu, F.MISC + 64};
        EpiDownW E{args.in[32], (const float*)(ws + WS_ROWGATE), (bf16*)(ws + WS_YS)};
        pg8::gemm_phase_w32<EpiDownW, MoeOrderW>(F.lds + RING_OFF, g, S, E);
#else
        pg8::Gemm g{DFF, DFF, DFF}; MoeOrder S{(const char*)(ws + WS_ACT), (const char*)(ws + WS_WTDN), (size_t)256 * DFF * 2, (size_t)256 * DFF * 2, (size_t)DM * DFF * 2, 8, F.G, F.vcu, F.MISC + 64};
        EpiDown E{args.in[32], (const float*)(ws + WS_ROWGATE), (bf16*)(ws + WS_YS)};
        pg8::gemm_phase<EpiDown, MoeOrder, true, true>(F.lds + RING_OFF, g, S, E);
#endif
        if (BOTH(11)) GRID_BAR();
    }
    PH(12) { if (N_LAUNCHES != 1) moe_table(F); final_rows(F, args, gw, NGW); }
#undef IN
#undef BOTH
}

extern "C" void kernel_launch(void* const* d_in, const int* in_sizes, int n_in, void* d_out, int out_size, void* d_ws, size_t ws_size, hipStream_t stream) {
    static int grid = 0;
    if (grid == 0) {
        if (n_in != 34 || out_size != SEQ * DM || ws_size < WS_END) { fprintf(stderr, "kernel_launch: unexpected shapes (n_in %d out %d ws %zu)\n", n_in, out_size, ws_size); grid = -1; return; }
        int dev = 0, cus = 0, per_cu = 0;
        if (hipGetDevice(&dev) != hipSuccess || hipDeviceGetAttribute(&cus, hipDeviceAttributeMultiprocessorCount, dev) != hipSuccess) { grid = -1; return; }
        if (hipFuncSetAttribute((const void*)fwd_kernel, hipFuncAttributeMaxDynamicSharedMemorySize, LDS_BYTES) != hipSuccess) { fprintf(stderr, "kernel_launch: hipFuncSetAttribute failed\n"); grid = -1; return; }
        if (hipOccupancyMaxActiveBlocksPerMultiprocessor(&per_cu, (const void*)fwd_kernel, NWAVES * 64, LDS_BYTES) != hipSuccess || per_cu < 1) fprintf(stderr, "kernel_launch: occupancy query reports %d\n", per_cu);
        (void)hipGetLastError();
        grid = cus;
    }
    if (grid < 0) return;
    (void)hipMemsetAsync((char*)d_ws + WS_CTL, 0, CTL_ZERO_BYTES, stream);
    Args a{};
    for (int i = 0; i < 34; ++i) a.in[i] = (const float*)d_in[i];
    a.out = (float*)d_out; a.ws = (unsigned char*)d_ws;
    if (N_LAUNCHES == 1) { a.ph_lo = 0; a.ph_hi = NPHASE; hipLaunchKernelGGL(fwd_kernel, dim3(grid), dim3(NWAVES * 64), LDS_BYTES, stream, a); }
    else for (int li = 0; li < NPHASE; ++li) { a.ph_lo = li; a.ph_hi = li + 1;
        for (int rep = 0; rep < 1 + ((REP_MASK >> li) & 1); ++rep) {
            if (rep > 0 && li == 8) (void)hipMemsetAsync((char*)d_ws + WS_CTL, 0, CTL_ZERO_BYTES, stream);
            hipLaunchKernelGGL(fwd_kernel, dim3(grid), dim3(NWAVES * 64), LDS_BYTES, stream, a); } }
}
```
